# Optimizing an MI355X kernel written in HIP

```python
import jax, jax.numpy as jnp
from jax import lax
import numpy as np

D_MODEL = 1024
BATCH = 4
SEQ = 8192
DEPTH = 2

N_META = 16
HGRN_HEAD_V = 128
HGRN_WIDTH = D_MODEL // 2
HGRN_HEADS = HGRN_WIDTH // HGRN_HEAD_V
HGRN_EXPAND = 128
HGRN_KDIM = HGRN_HEADS * HGRN_EXPAND
CHUNK = 64
POOL_WINDOWS = (2, 4, 8, 16)
POOL_GROUPS = len(POOL_WINDOWS)
POOL_WIDTH = D_MODEL // 2
POOL_GROUP_DIM = POOL_WIDTH // POOL_GROUPS
D_FF = 2816
CONV_WIDTH = 3
EPS = 1e-6
LOG_FLOOR = 1e-30
SPLITS = (HGRN_KDIM, HGRN_KDIM, HGRN_WIDTH, HGRN_WIDTH, POOL_WIDTH, D_MODEL, D_MODEL)
IN_COLS = sum(SPLITS)

kernel_name = "hybrid_hgrn2_pool_convffn_trunk"


def rmsnorm(x, gain):
    xf = x.astype(jnp.float32)
    y = xf * lax.rsqrt(jnp.mean(xf * xf, axis=-1, keepdims=True) + EPS)
    return (y * gain.astype(jnp.float32)).astype(x.dtype)


def _hgrn2_chunk_step(state, xs):
    q, k, v, lf = xs
    c = q.shape[2]
    b = jnp.cumsum(lf, axis=2)
    o_inter = jnp.einsum('bhtk,bhkv->bhtv', q * jnp.exp(b), state)
    diff = b[:, :, :, None, :] - b[:, :, None, :, :]
    causal = (jnp.arange(c)[:, None] >= jnp.arange(c)[None, :])[None, None, :, :, None]
    decay = jnp.where(causal, jnp.exp(jnp.where(causal, diff, 0.0)), 0.0)
    scores = jnp.einsum('bhtk,bhtsk,bhsk->bhts', q, decay, k)
    o_intra = jnp.einsum('bhts,bhsv->bhtv', scores, v)
    b_last = b[:, :, -1, :]
    k_dec = k * jnp.exp(b_last[:, :, None, :] - b)
    new_state = jnp.exp(b_last)[..., None] * state + jnp.einsum('bhsk,bhsv->bhkv', k_dec, v)
    return new_state, o_inter + o_intra


def hgrn2(q, f_logit, i, g, lb, out_gain):
    bsz, L, _ = q.shape
    lb = lb.astype(jnp.float32)
    fl = f_logit.astype(jnp.float32)
    f = lb + (1.0 - lb) * jax.nn.sigmoid(fl)
    log_f = jnp.log(jnp.maximum(f, LOG_FLOOR))
    k = (1.0 - lb) * jax.nn.sigmoid(-fl)
    pad = CHUNK - N_META
    def prep(t, d):
        t = jnp.pad(t.astype(jnp.float32), ((0, 0), (pad, 0), (0, 0)))
        n = t.shape[1] // CHUNK
        return t.reshape(bsz, n, CHUNK, HGRN_HEADS, d).transpose(1, 0, 3, 2, 4)
    xs = (prep(q, HGRN_EXPAND), prep(k, HGRN_EXPAND), prep(i, HGRN_HEAD_V), prep(log_f, HGRN_EXPAND))
    state0 = jnp.zeros((bsz, HGRN_HEADS, HGRN_EXPAND, HGRN_HEAD_V), jnp.float32)
    _, o = lax.scan(_hgrn2_chunk_step, state0, xs)
    o = o.transpose(1, 0, 3, 2, 4).reshape(bsz, -1, HGRN_HEADS, HGRN_HEAD_V)[:, pad:]
    o = o * lax.rsqrt(jnp.mean(o * o, axis=-1, keepdims=True) + EPS)
    o = o.reshape(bsz, L, HGRN_WIDTH) * out_gain.astype(jnp.float32)
    return o * jax.nn.sigmoid(g.astype(jnp.float32))


def multiscale_pool(v, proj, scale):
    bsz, L, _ = v.shape
    vg = v.astype(jnp.float32).reshape(bsz, L, POOL_GROUPS, POOL_GROUP_DIM)
    cs0 = jnp.pad(jnp.cumsum(vg, axis=1), ((0, 0), (1, 0), (0, 0), (0, 0)))
    t1 = jnp.arange(1, L + 1)
    outs = []
    for gi, w in enumerate(POOL_WINDOWS):
        hi = cs0[:, 1:, gi]
        lo = jnp.pad(cs0[:, :L + 1 - w, gi], ((0, 0), (w - 1, 0), (0, 0)))
        cnt = jnp.minimum(t1, w).astype(jnp.float32)[None, :, None]
        outs.append((hi - lo) / cnt - vg[:, :, gi])
    pooled = jnp.stack(outs, axis=2)
    y = jnp.einsum('blgc,gcd->blgd', pooled, proj.astype(jnp.float32))
    return y.reshape(bsz, L, POOL_WIDTH) * scale.astype(jnp.float32)


def causal_dwconv(x, w, b):
    L = x.shape[1]
    xp = jnp.pad(x, ((0, 0), (CONV_WIDTH - 1, 0), (0, 0)))
    y = b
    for j in range(CONV_WIDTH):
        y = y + xp[:, j:j + L] * w[j]
    return y


def setup_inputs(seed: int = 0) -> dict:
    key = jax.random.key(seed)
    ks = jax.random.split(key, 24)
    nrm = lambda k, shape, s: jax.random.normal(k, shape, jnp.float32) * s
    gain = lambda k, shape: 1.0 + nrm(k, shape, 0.05)
    return {
        "x": nrm(ks[0], (BATCH, SEQ, D_MODEL), 1.0),
        "meta_tokens": nrm(ks[1], (N_META, D_MODEL), 1.0),
        "mix_norm_pre": gain(ks[2], (DEPTH, D_MODEL)),
        "mix_norm_post": gain(ks[3], (DEPTH, D_MODEL)),
        "w_in": nrm(ks[4], (DEPTH, D_MODEL, IN_COLS), D_MODEL ** -0.5),
        "hgrn_lower_bounds": nrm(ks[5], (DEPTH, HGRN_KDIM), 0.5),
        "hgrn_out_norm": gain(ks[6], (DEPTH, HGRN_WIDTH)),
        "w_branch_hgrn": nrm(ks[7], (DEPTH, HGRN_WIDTH, D_MODEL), HGRN_WIDTH ** -0.5),
        "pool_proj": nrm(ks[8], (DEPTH, POOL_GROUPS, POOL_GROUP_DIM, POOL_GROUP_DIM), POOL_GROUP_DIM ** -0.5),
        "pool_scale": gain(ks[9], (DEPTH, POOL_WIDTH)),
        "w_branch_pool": nrm(ks[10], (DEPTH, POOL_WIDTH, D_MODEL), POOL_WIDTH ** -0.5),
        "w_out": nrm(ks[11], (DEPTH, D_MODEL, D_MODEL), D_MODEL ** -0.5),
        "ffn_norm_pre": gain(ks[12], (DEPTH, D_MODEL)),
        "ffn_norm_post": gain(ks[13], (DEPTH, D_MODEL)),
        "ffn_w_gate": nrm(ks[14], (DEPTH, D_MODEL, D_FF), D_MODEL ** -0.5),
        "ffn_w_up": nrm(ks[15], (DEPTH, D_MODEL, D_FF), D_MODEL ** -0.5),
        "ffn_conv_w": nrm(ks[16], (DEPTH, CONV_WIDTH, D_FF), CONV_WIDTH ** -0.5),
        "ffn_conv_b": nrm(ks[17], (DEPTH, D_FF), 0.02),
        "ffn_w_down": nrm(ks[18], (DEPTH, D_FF, D_MODEL), D_FF ** -0.5),
    }


def reference(x, meta_tokens, mix_norm_pre, mix_norm_post, w_in, hgrn_lower_bounds, hgrn_out_norm,
              w_branch_hgrn, pool_proj, pool_scale, w_branch_pool, w_out, ffn_norm_pre, ffn_norm_post,
              ffn_w_gate, ffn_w_up, ffn_conv_w, ffn_conv_b, ffn_w_down):
    bsz = x.shape[0]
    meta = jnp.broadcast_to(meta_tokens[None].astype(x.dtype), (bsz, N_META, D_MODEL))
    h = jnp.concatenate([meta, x], axis=1)
    gam = jax.nn.softmax(hgrn_lower_bounds.astype(jnp.float32), axis=0)
    lbs = jnp.clip(jnp.cumsum(gam, axis=0) - gam[0], 0.0, 1.0)
    cuts = list(np.cumsum(SPLITS)[:-1])
    for l in range(DEPTH):
        u = rmsnorm(h, mix_norm_pre[l])
        proj = u @ w_in[l]
        q, f_logit, i_in, g_out, v_pool, gate_a, gate_b = jnp.split(proj, cuts, axis=-1)
        a = hgrn2(q, f_logit, i_in, g_out, lbs[l], hgrn_out_norm[l])
        p = multiscale_pool(v_pool, pool_proj[l], pool_scale[l])
        z = (jax.nn.sigmoid(gate_a.astype(jnp.float32)) * (a @ w_branch_hgrn[l])
             + jax.nn.sigmoid(gate_b.astype(jnp.float32)) * (p @ w_branch_pool[l]))
        h = h + rmsnorm(z @ w_out[l], mix_norm_post[l])
        u = rmsnorm(h, ffn_norm_pre[l])
        gt = causal_dwconv(u @ ffn_w_gate[l], ffn_conv_w[l], ffn_conv_b[l])
        y = (jax.nn.gelu(gt, approximate=True) * (u @ ffn_w_up[l])) @ ffn_w_down[l]
        h = h + rmsnorm(y, ffn_norm_post[l])
    return h[:, N_META:]
```

```cpp
#include <hip/hip_runtime.h>
#include <cstdio>
#include <cstdint>

#ifndef MK_ONE_LAUNCH
#define MK_ONE_LAUNCH 0
#endif

#define LAS __attribute__((address_space(3)))
#define GAS __attribute__((address_space(1)))
typedef unsigned short bf16;
typedef short bf16x8 __attribute__((ext_vector_type(8)));
typedef float f32x4 __attribute__((ext_vector_type(4)));
typedef float f32x2 __attribute__((ext_vector_type(2)));
typedef unsigned u32x4 __attribute__((ext_vector_type(4)));
typedef unsigned u32x2 __attribute__((ext_vector_type(2)));

constexpr int NB = 4, SEQ = 8192, D = 1024, NMETA = 16, DEPTH = 2;
constexpr int MX = NB * SEQ;
constexpr int MROWS = MX + 256;
constexpr int META0 = MX;
constexpr int DFF = 2816, INC = 4608;
constexpr int NA = 2560;
constexpr int NG = 2048;
constexpr int NGU = 2 * DFF;
constexpr float EPS = 1e-6f;

constexpr size_t A256(size_t x) { return (x + 255) & ~(size_t)255; }
constexpr size_t WS_CTL = 0, CTL_BYTES = 1u << 20;
constexpr size_t WL_INA = 0, WL_G = WL_INA + (size_t)NA * D * 2, WL_Z = WL_G + (size_t)NG * D * 2, WL_OUT = WL_Z + (size_t)D * D * 2,
                 WL_GU = WL_OUT + (size_t)D * D * 2, WL_DN = WL_GU + (size_t)NGU * D * 2, WL_BYTES = WL_DN + (size_t)D * DFF * 2;
constexpr size_t WS_W = CTL_BYTES;
constexpr size_t WS_LB = A256(WS_W + DEPTH * WL_BYTES);
constexpr size_t WS_HB = A256(WS_LB + 2 * 512 * 4);
constexpr size_t WS_HM = A256(WS_HB + (size_t)MROWS * D * 2);
constexpr size_t WS_RS = A256(WS_HM + (size_t)256 * D * 4);
constexpr size_t WS_BIG = A256(WS_RS + (size_t)MROWS * 4);
constexpr size_t B_PA = 0;
constexpr size_t B_AP = A256(B_PA + (size_t)MROWS * NA * 2);
constexpr size_t B_Z = A256(B_AP + (size_t)MROWS * D * 2);
constexpr size_t B_KV = A256(B_Z + (size_t)MROWS * D * 2);
constexpr size_t B_SS = B_KV + (size_t)256 * 16384 * 4;
constexpr size_t B_SM = B_SS + (size_t)256 * 16384 * 4;
constexpr size_t B_DD = B_SM + (size_t)4 * 16384 * 4;
constexpr size_t B_MIX_END = B_DD + (size_t)256 * 128 * 4;
constexpr size_t B_G = 0;
constexpr size_t B_U = A256(B_G + (size_t)MROWS * DFF * 2);
constexpr size_t B_FFN_END = B_U + (size_t)MROWS * DFF * 2;
constexpr size_t BIG_BYTES = B_FFN_END > B_MIX_END ? B_FFN_END : B_MIX_END;
constexpr size_t WS_END = WS_BIG + BIG_BYTES;
static_assert((size_t)MROWS * D * 4 <= (size_t)MROWS * NA * 2 && (size_t)MROWS * NG * 2 <= (size_t)MROWS * NA * 2, "Y1 / gates overlay proj_a");
static_assert((size_t)MROWS * D * 4 <= (size_t)MROWS * DFF * 2, "Y2 overlays G");
static_assert(WS_END <= 536870912ull, "d_ws map exceeds 512 MiB");

constexpr int CW_TMO = 0;
constexpr int CW_BAR = 4096;

constexpr int LDS_BYTES = 147456;
constexpr int MISC_OFF = LDS_BYTES - 256;

__device__ __forceinline__ unsigned f2bf(float f) { unsigned u = __builtin_bit_cast(unsigned, f); return (u + 0x7fffu + ((u >> 16) & 1u)) >> 16; }
__device__ __forceinline__ unsigned pk2(float lo, float hi) { return f2bf(lo) | (f2bf(hi) << 16); }
__device__ __forceinline__ float bflo(unsigned w) { return __builtin_bit_cast(float, w << 16); }
__device__ __forceinline__ float bfhi(unsigned w) { return __builtin_bit_cast(float, w & 0xffff0000u); }
__device__ __forceinline__ float fsigmoid(float x) { return 1.0f / (1.0f + __expf(-x)); }
__device__ __forceinline__ float wave_sum(float v) {
#pragma unroll
    for (int o = 1; o < 64; o <<= 1) v += __shfl_xor(v, o);
    return v;
}
#define LDS_WAIT() asm volatile("s_waitcnt lgkmcnt(0)" ::: "memory")
#define VM_WAIT() asm volatile("s_waitcnt vmcnt(0)" ::: "memory")

namespace pg8 {
#define PG8_LAS __attribute__((address_space(3)))
typedef unsigned short bf16_t;
constexpr int BM = 256, BK = 64, HALF = 128, HTB = HALF * BK * 2, STAGE_BYTES = 8 * HTB, NXCD = 8, WGM = 8;
__host__ __device__ __forceinline__ int lds_byte(int r, int c) { const int st = (r >> 4) * 2 + (c >> 5), rr = r & 15, cc = c & 31, ob = rr * 64 + cc * 2; return st * 1024 + (ob ^ (((ob >> 9) & 1) << 5)); }
__host__ __device__ __forceinline__ void stage_rc(int b, int& R, int& C) { const int st = b / 1024, sb = b % 1024, swz = sb ^ (((sb >> 9) & 1) << 5); R = (st >> 1) * 16 + swz / 64; C = (st & 1) * 32 + (swz % 64) / 2; }
__host__ __device__ __forceinline__ int perm32(int rho) { const int n = rho >> 4, i = rho & 15; return 8 * (i >> 2) + 4 * n + (i & 3); }

struct Unit { int pm, pn, half; };
struct Gemm { const bf16_t* A; const bf16_t* Bt; int lda, ldb, K, khalf; };

struct StaticOrder {
    int nM, nN, nwg, G, c;
    __host__ __device__ void init(int M, int N, int G_, int c_) { nM = M / BM; nN = N / BM; nwg = nM * nN; G = G_; c = c_; }
    __host__ __device__ bool tile(int i, Unit& u) const {
        const long L = (long)i * G + c; if (L >= nwg) return false;
        int wgid = (int)L; { const int q = nwg / NXCD, r = nwg % NXCD, xcd = wgid % NXCD, off = wgid / NXCD; wgid = (xcd < r ? xcd * (q + 1) : r * (q + 1) + (xcd - r) * q) + off; }
        const int nig = WGM * nN, gid = wgid / nig, fm = gid * WGM, gsz = (nM - fm) < WGM ? (nM - fm) : WGM;
        u.pm = fm + ((wgid % nig) % gsz); u.pn = (wgid % nig) / gsz; u.half = 0; return true;
    }
    __host__ __device__ bool next(int i, Unit& u) const { return tile(i, u); }
};
struct PairOrder : StaticOrder {
    __host__ __device__ bool next(int i, Unit& u) const { if (!tile(i >> 1, u)) return false; u.half = i & 1; return true; }
};

__device__ __forceinline__ unsigned cvt_pk_bf16(float lo, float hi) { unsigned r; asm volatile("v_cvt_pk_bf16_f32 %0, %1, %2" : "=v"(r) : "v"(lo), "v"(hi)); return r; }

typedef f32x4 Acc[2][2][4][2];

template <class Epi, class Sched, bool ALIGN_EPI>
__device__ __forceinline__ void gemm_phase(PG8_LAS unsigned char* lds, const Gemm g, const Sched& S, const Epi& E, const int tid) {
    const int wid = __builtin_amdgcn_readfirstlane(tid >> 6), lane = tid & 63, wr = wid >> 2, wc = wid & 3, fr = lane & 15, fq = lane >> 4;
    const int nt = g.K / BK;
    unsigned voffA[2], voffB[2];
#pragma unroll
    for (int i = 0; i < 2; ++i) { int R, C; stage_rc(tid * 16 + i * 8192, R, C); const int Rb = Epi::PERM ? ((R & ~31) + perm32(R & 31)) : R;
        voffA[i] = (unsigned)(R * g.lda + C) * 2u; voffB[i] = (unsigned)(Rb * g.ldb + C) * 2u; }
    const size_t kstep = (size_t)(BK * 2);
    const size_t hstepA = (size_t)HALF * g.lda * 2, hstepB = (size_t)HALF * g.ldb * 2;
    const unsigned ldsw = (unsigned)wid * 1024u;
    const int aoff = lds_byte(wr * 64 + fr, fq * 8), boff = lds_byte(wc * 32 + fr, fq * 8);
#define PG8_SA(b, h) (((b) * 2 + (h)) * HTB)
#define PG8_SB(b, h) ((4 + (b) * 2 + (h)) * HTB)
#define PG8_STAGE(bufoff, gbase, voff) do { _Pragma("unroll") for (int _i = 0; _i < 2; ++_i) \
        __builtin_amdgcn_global_load_lds((const unsigned*)((const char*)(gbase) + (voff)[_i]), (PG8_LAS unsigned*)(lds + (bufoff) + ldsw + _i * 8192), 16, 0, 0); } while (0)
#define PG8_LDA(dst, b, h) do { _Pragma("unroll") for (int m = 0; m < 4; ++m) _Pragma("unroll") for (int k = 0; k < 2; ++k) dst[m][k] = *(const PG8_LAS bf16x8*)(lds + PG8_SA(b, h) + aoff + m * 2048 + k * 1024); } while (0)
#define PG8_LDB(dst, b, h) do { _Pragma("unroll") for (int n = 0; n < 2; ++n) _Pragma("unroll") for (int k = 0; k < 2; ++k) dst[n][k] = *(const PG8_LAS bf16x8*)(lds + PG8_SB(b, h) + boff + n * 2048 + k * 1024); } while (0)
#define PG8_MMA(ai, bj, At, Bt) do { __builtin_amdgcn_s_setprio(1); _Pragma("unroll") for (int m = 0; m < 4; ++m) _Pragma("unroll") for (int n = 0; n < 2; ++n) _Pragma("unroll") for (int k = 0; k < 2; ++k) \
        acc[ai][bj][m][n] = __builtin_amdgcn_mfma_f32_16x16x32_bf16(Bt[n][k], At[m][k], acc[ai][bj][m][n], 0, 0, 0); __builtin_amdgcn_s_setprio(0); } while (0)
#define PG8_WAIT_V(n) asm volatile("s_waitcnt vmcnt(" #n ")" ::: "memory")
#define PG8_WAIT_L(n) asm volatile("s_waitcnt lgkmcnt(" #n ")" ::: "memory")
#define PG8_BAR __builtin_amdgcn_s_barrier()
#define PG8_SCHED __builtin_amdgcn_sched_barrier(0)
#define PG8_UA(u) ((const char*)g.A + (size_t)(u).pm * 2 * hstepA + (size_t)(u).half * g.khalf * 2)
#define PG8_UB(u) ((const char*)g.Bt + (size_t)(u).pn * 2 * hstepB + (size_t)(u).half * g.khalf * 2)
    Unit cur, nxt; int ui = 0;
    if (!S.next(0, cur)) return;
    Acc acc;
#pragma unroll
    for (int a = 0; a < 2; ++a)
#pragma unroll
        for (int b = 0; b < 2; ++b)
#pragma unroll
            for (int m = 0; m < 4; ++m)
#pragma unroll
                for (int n = 0; n < 2; ++n) acc[a][b][m][n] = (f32x4){0.f, 0.f, 0.f, 0.f};
    bf16x8 At[4][2], B0[2][2], B1[2][2];
    const char* cA = PG8_UA(cur); const char* cB = PG8_UB(cur);
    PG8_STAGE(PG8_SB(0, 0), cB, voffB); PG8_STAGE(PG8_SB(0, 1), cB + hstepB, voffB); PG8_STAGE(PG8_SA(0, 0), cA, voffA); PG8_STAGE(PG8_SA(0, 1), cA + hstepA, voffA);
    if (wr == 1) PG8_BAR;
    PG8_WAIT_V(2); PG8_BAR;
    PG8_STAGE(PG8_SB(1, 0), cB + kstep, voffB); PG8_STAGE(PG8_SA(1, 0), cA + kstep, voffA); PG8_STAGE(PG8_SB(1, 1), cB + hstepB + kstep, voffB);
    PG8_WAIT_V(6); PG8_BAR;
    for (;;) {
        const bool has_next = S.next(ui + 1, nxt);
        const char* nA = has_next ? PG8_UA(nxt) : cA; const char* nB = has_next ? PG8_UB(nxt) : cB;
        for (int t = 0; t < nt; t += 2) {
            const bool last = (t == nt - 2);
            const char* a1 = cA + (size_t)(t + 1) * kstep;
            const char* a2 = last ? nA : cA + (size_t)(t + 2) * kstep; const char* b2 = last ? nB : cB + (size_t)(t + 2) * kstep;
            const char* a3 = a2 + kstep; const char* b3 = b2 + kstep;
            PG8_LDB(B0, 0, 0); PG8_LDB(B1, 0, 1); PG8_SCHED; PG8_LDA(At, 0, 0); PG8_STAGE(PG8_SA(1, 1), a1 + hstepA, voffA);
            PG8_WAIT_V(8); PG8_WAIT_L(0); PG8_BAR; PG8_MMA(0, 0, At, B0); PG8_MMA(0, 1, At, B1); PG8_BAR; PG8_SCHED;
            PG8_LDA(At, 0, 1); PG8_STAGE(PG8_SB(0, 0), b2, voffB); PG8_STAGE(PG8_SB(0, 1), b2 + hstepB, voffB); PG8_STAGE(PG8_SA(0, 0), a2, voffA);
            PG8_WAIT_V(8); PG8_WAIT_L(0); PG8_BAR; PG8_MMA(1, 0, At, B0); PG8_MMA(1, 1, At, B1); PG8_BAR; PG8_SCHED;
            PG8_LDB(B0, 1, 0); PG8_LDB(B1, 1, 1); PG8_SCHED; PG8_LDA(At, 1, 0); PG8_STAGE(PG8_SA(0, 1), a2 + hstepA, voffA);
            PG8_WAIT_V(8); PG8_WAIT_L(0); PG8_BAR; PG8_MMA(0, 0, At, B0); PG8_MMA(0, 1, At, B1); PG8_BAR; PG8_SCHED;
            PG8_LDA(At, 1, 1); PG8_STAGE(PG8_SB(1, 0), b3, voffB); PG8_STAGE(PG8_SB(1, 1), b3 + hstepB, voffB); PG8_STAGE(PG8_SA(1, 0), a3, voffA);
            PG8_WAIT_V(8); PG8_WAIT_L(0); PG8_BAR; PG8_MMA(1, 0, At, B0); PG8_MMA(1, 1, At, B1); PG8_BAR; PG8_SCHED;
        }
        if constexpr (ALIGN_EPI) { if (wr == 0) PG8_BAR; }
        E(acc, cur, wr, wc, fr, fq);
        if (!has_next) break;
        if (!E.keep(cur)) {
#pragma unroll
            for (int a = 0; a < 2; ++a)
#pragma unroll
                for (int b = 0; b < 2; ++b)
#pragma unroll
                    for (int m = 0; m < 4; ++m)
#pragma unroll
                        for (int n = 0; n < 2; ++n) acc[a][b][m][n] = (f32x4){0.f, 0.f, 0.f, 0.f};
        }
        cur = nxt; cA = nA; cB = nB; ++ui;
        if constexpr (ALIGN_EPI) { if (wr == 1) PG8_BAR; }
    }
    PG8_WAIT_V(0);
    if constexpr (!ALIGN_EPI) { if (wr == 0) PG8_BAR; }
    PG8_BAR;
#undef PG8_SA
#undef PG8_SB
#undef PG8_STAGE
#undef PG8_LDA
#undef PG8_LDB
#undef PG8_MMA
#undef PG8_WAIT_V
#undef PG8_WAIT_L
#undef PG8_BAR
#undef PG8_SCHED
#undef PG8_UA
#undef PG8_UB
}

struct EpiProjA {
    static constexpr bool PERM = true;
    bf16_t* O; const float* rs;
    __device__ __forceinline__ bool keep(const Unit&) const { return false; }
    __device__ __forceinline__ void operator()(Acc& acc, const Unit& u, int wr, int wc, int fr, int fq) const {
        const int row0 = u.pm * BM + wr * 64 + fr, col0 = u.pn * BM + wc * 32 + 8 * fq;
        const bool sig = (u.pn == 6 || u.pn == 7);
#pragma unroll
        for (int ai = 0; ai < 2; ++ai)
#pragma unroll
            for (int m = 0; m < 4; ++m) { const int r = row0 + ai * HALF + m * 16; const float s = rs[r]; bf16_t* rowp = O + (size_t)r * NA + col0;
#pragma unroll
                for (int bj = 0; bj < 2; ++bj) { f32x4 v0 = acc[ai][bj][m][0] * s, v1 = acc[ai][bj][m][1] * s;
                    if (sig) {
#pragma unroll
                        for (int e = 0; e < 4; ++e) { v0[e] = fsigmoid(v0[e]); v1[e] = fsigmoid(v1[e]); } }
                    u32x4 w; w.x = cvt_pk_bf16(v0[0], v0[1]); w.y = cvt_pk_bf16(v0[2], v0[3]); w.z = cvt_pk_bf16(v1[0], v1[1]); w.w = cvt_pk_bf16(v1[2], v1[3]);
                    *(u32x4*)(rowp + bj * HALF) = w; } }
    }
};
struct EpiGates {
    static constexpr bool PERM = true;
    bf16_t* O; const float* rs;
    __device__ __forceinline__ bool keep(const Unit&) const { return false; }
    __device__ __forceinline__ void operator()(Acc& acc, const Unit& u, int wr, int wc, int fr, int fq) const {
        const int row0 = u.pm * BM + wr * 64 + fr, col0 = u.pn * HALF + wc * 32 + 8 * fq;
#pragma unroll
        for (int ai = 0; ai < 2; ++ai)
#pragma unroll
            for (int m = 0; m < 4; ++m) { const int r = row0 + ai * HALF + m * 16; const float s = rs[r]; bf16_t* rowp = O + (size_t)r * NG + col0;
                float R[8], SB[8];
#pragma unroll
                for (int n = 0; n < 2; ++n)
#pragma unroll
                    for (int e = 0; e < 4; ++e) { const float ga = acc[ai][0][m][n][e] * s, gb = acc[ai][1][m][n][e] * s;
                        const float ea = __expf(-ga), eb = __expf(-gb); const float sb = 1.0f / (1.0f + eb);
                        SB[n * 4 + e] = sb; R[n * 4 + e] = (1.0f + eb) / (1.0f + ea); }
                u32x4 w; w.x = cvt_pk_bf16(R[0], R[1]); w.y = cvt_pk_bf16(R[2], R[3]); w.z = cvt_pk_bf16(R[4], R[5]); w.w = cvt_pk_bf16(R[6], R[7]);
                *(u32x4*)(rowp) = w;
                w.x = cvt_pk_bf16(SB[0], SB[1]); w.y = cvt_pk_bf16(SB[2], SB[3]); w.z = cvt_pk_bf16(SB[4], SB[5]); w.w = cvt_pk_bf16(SB[6], SB[7]);
                *(u32x4*)(rowp + 1024) = w; }
    }
};
struct EpiZ {
    static constexpr bool PERM = true;
    const bf16_t* GT; bf16_t* Z;
    __device__ __forceinline__ bool keep(const Unit& u) const { return u.half == 0; }
    __device__ __forceinline__ void operator()(Acc& acc, const Unit& u, int wr, int wc, int fr, int fq) const {
        const int row0 = u.pm * BM + wr * 64 + fr, col0 = u.pn * BM + wc * 32 + 8 * fq;
        const int goff = (u.half == 0) ? 0 : 1024;
#pragma unroll
        for (int ai = 0; ai < 2; ++ai)
#pragma unroll
            for (int m = 0; m < 4; ++m) { const int r = row0 + ai * HALF + m * 16;
#pragma unroll
                for (int bj = 0; bj < 2; ++bj) { const u32x4 gw = *(const u32x4*)(GT + (size_t)r * NG + goff + col0 + bj * HALF);
                    const f32x4 g0 = (f32x4){bflo(gw.x), bfhi(gw.x), bflo(gw.y), bfhi(gw.y)}, g1 = (f32x4){bflo(gw.z), bfhi(gw.z), bflo(gw.w), bfhi(gw.w)};
                    const f32x4 v0 = acc[ai][bj][m][0] * g0, v1 = acc[ai][bj][m][1] * g1;
                    if (u.half == 0) { acc[ai][bj][m][0] = v0; acc[ai][bj][m][1] = v1; }
                    else { u32x4 w; w.x = cvt_pk_bf16(v0[0], v0[1]); w.y = cvt_pk_bf16(v0[2], v0[3]); w.z = cvt_pk_bf16(v1[0], v1[1]); w.w = cvt_pk_bf16(v1[2], v1[3]);
                        *(u32x4*)(Z + (size_t)r * D + col0 + bj * HALF) = w; } } }
    }
};
struct EpiF32 {
    static constexpr bool PERM = false;
    float* C; int ldc;
    __device__ __forceinline__ bool keep(const Unit&) const { return false; }
    __device__ __forceinline__ void operator()(Acc& acc, const Unit& u, int wr, int wc, int fr, int fq) const {
        const int row0 = u.pm * BM + wr * 64 + fr, col0 = u.pn * BM + wc * 32 + 4 * fq;
#pragma unroll
        for (int ai = 0; ai < 2; ++ai)
#pragma unroll
            for (int m = 0; m < 4; ++m) { float* rowp = C + (size_t)(row0 + ai * HALF + m * 16) * ldc + col0;
#pragma unroll
                for (int bj = 0; bj < 2; ++bj)
#pragma unroll
                    for (int n = 0; n < 2; ++n) *(f32x4*)(rowp + bj * HALF + n * 16) = acc[ai][bj][m][n]; }
    }
};
struct EpiGU {
    static constexpr bool PERM = true;
    bf16_t* G; bf16_t* U; const float* rs;
    __device__ __forceinline__ bool keep(const Unit&) const { return false; }
    __device__ __forceinline__ void operator()(Acc& acc, const Unit& u, int wr, int wc, int fr, int fq) const {
        const int row0 = u.pm * BM + wr * 64 + fr, col0 = u.pn * HALF + wc * 32 + 8 * fq;
#pragma unroll
        for (int ai = 0; ai < 2; ++ai)
#pragma unroll
            for (int m = 0; m < 4; ++m) { const int r = row0 + ai * HALF + m * 16; const float s = rs[r];
#pragma unroll
                for (int bj = 0; bj < 2; ++bj) { const f32x4 v0 = acc[ai][bj][m][0] * s, v1 = acc[ai][bj][m][1] * s;
                    u32x4 w; w.x = cvt_pk_bf16(v0[0], v0[1]); w.y = cvt_pk_bf16(v0[2], v0[3]); w.z = cvt_pk_bf16(v1[0], v1[1]); w.w = cvt_pk_bf16(v1[2], v1[3]);
                    *(u32x4*)((bj == 0 ? G : U) + (size_t)r * DFF + col0) = w; } }
    }
};
}

#define XB_TMO      128
#define XB_XCNT(j)  (256  + 64 * (j))
#define XB_XSUB(j)  (1280 + 64 * (j))
#define XB_XGEN(j)  (2304 + 64 * (j))
#define XB_TOP      3328
#define XB_TOPGEN   3392
#define XCD_BAR_WORDS 3456
#define XB_SPIN_CAP (1u << 18)
__device__ __forceinline__ unsigned xb_ld(unsigned* p)              { return __hip_atomic_load(p, __ATOMIC_RELAXED, __HIP_MEMORY_SCOPE_AGENT); }
__device__ __forceinline__ unsigned xb_add(unsigned* p, unsigned v) { return __hip_atomic_fetch_add(p, v, __ATOMIC_RELAXED, __HIP_MEMORY_SCOPE_AGENT); }
__device__ __forceinline__ unsigned xb_xcc_id() { return (unsigned)__builtin_amdgcn_s_getreg((3 << 11) | 20) & 0xFu; }
#define XB_SPIN(cond, bar) do { unsigned _sp = 0; while (cond) { __builtin_amdgcn_s_sleep(1); \
    if ((++_sp & 255u) == 0u) { if (xb_ld(&(bar)[XB_TMO])) break; if (_sp > XB_SPIN_CAP) { atomicAdd(&(bar)[XB_TMO], 1u); break; } } } } while (0)
struct XcdBarrier { unsigned* bar; unsigned x; volatile LAS unsigned* st; };
__device__ __forceinline__ XcdBarrier xcd_barrier_post(unsigned* bar, volatile LAS unsigned* st) {
    XcdBarrier b; b.bar = bar; b.x = xb_xcc_id(); b.st = st;
    if (threadIdx.x == 0) (void)xb_add(&bar[XB_XCNT(b.x)], 1u);
    return b;
}
__device__ __forceinline__ void xcd_barrier_complete(unsigned* bar, unsigned x, unsigned& nloc, unsigned& nx) {
    const unsigned G = gridDim.x * gridDim.y * gridDim.z;
    unsigned sum, cnt, mine, sp = 0u;
    for (;;) {
        sum = 0u; cnt = 0u; mine = 0u;
#pragma unroll
        for (unsigned j = 0; j < 16; ++j) { const unsigned c = xb_ld(&bar[XB_XCNT(j)]); sum += c; cnt += (c > 0u) ? 1u : 0u; mine = (j == x) ? c : mine; }
        if (sum == G) break;
        __builtin_amdgcn_s_sleep(1);
        if ((++sp & 255u) == 0u) { if (xb_ld(&bar[XB_TMO])) break; if (sp > XB_SPIN_CAP) { atomicAdd(&bar[XB_TMO], 1u); break; } }
    }
    nloc = mine > 0u ? mine : 1u; nx = cnt > 0u ? cnt : 1u;
}
__device__ __forceinline__ void xcd_barrier(const XcdBarrier& b) {
    asm volatile("s_waitcnt vmcnt(0)" ::: "memory");
    __syncthreads();
    if (threadIdx.x == 0) {
        unsigned* bar = b.bar;
        __builtin_amdgcn_s_waitcnt(0);
        unsigned nloc = b.st[0], nx = b.st[1];
        if (nloc == 0u) { xcd_barrier_complete(bar, b.x, nloc, nx); b.st[0] = nloc; b.st[1] = nx; }
        const unsigned old = xb_add(&bar[XB_XSUB(b.x)], 1u);
        const unsigned gen = old / nloc;
        if (old + 1u == (gen + 1u) * nloc) {
            __builtin_amdgcn_fence(__ATOMIC_RELEASE, "agent");
            asm volatile("s_waitcnt vmcnt(0)" ::: "memory");
            const unsigned og = xb_add(&bar[XB_TOP], 1u);
            const unsigned tg = og / nx;
            if (og + 1u == (tg + 1u) * nx) xb_add(&bar[XB_TOPGEN], 1u);
            else XB_SPIN(xb_ld(&bar[XB_TOPGEN]) == tg, bar);
            __builtin_amdgcn_fence(__ATOMIC_ACQUIRE, "agent");
            xb_add(&bar[XB_XGEN(b.x)], 1u);
            asm volatile("s_waitcnt vmcnt(0)" ::: "memory");
        } else {
            XB_SPIN(xb_ld(&bar[XB_XGEN(b.x)]) == gen, bar);
            __builtin_amdgcn_fence(__ATOMIC_ACQUIRE, "agent");
            asm volatile("s_waitcnt vmcnt(0)" ::: "memory");
        }
    }
    __syncthreads();
}

struct Frame {
    LAS unsigned char* lds;
    int tid, lane, wave, vcu, G;
    const float* in[19]; float* out; unsigned char* ws;
};
__device__ __forceinline__ float* hrow_ptr(const Frame& F, int r) { return r < MX ? F.out + (size_t)r * D : (float*)(F.ws + WS_HM) + (size_t)(r - MX) * D; }
__device__ __forceinline__ int prev_row(int r, int j) {
    if (r < MX) { const int t = r & (SEQ - 1); if (t >= j) return r - j; const int m = NMETA + t - j; return m >= 0 ? META0 + m : -1; }
    const int m = r - META0 - j; return m >= 0 ? META0 + m : -1;
}

__device__ __forceinline__ void tr_store(LAS float* scr, bf16* dst, int ldd, int n0d, int kd0, int lane) {
    LDS_WAIT(); asm volatile("" ::: "memory");
    const int c = lane & 7;
#pragma unroll
    for (int j = 0; j < 4; ++j) { const int n = (lane >> 3) + 8 * j; const LAS float* s = scr + (8 * c) * 33 + n;
        u32x4 o; o.x = pk2(s[0 * 33], s[1 * 33]); o.y = pk2(s[2 * 33], s[3 * 33]); o.z = pk2(s[4 * 33], s[5 * 33]); o.w = pk2(s[6 * 33], s[7 * 33]);
        *(u32x4*)(dst + (size_t)(n0d + n) * ldd + kd0 + 8 * c) = o; }
    LDS_WAIT(); asm volatile("" ::: "memory");
}
__device__ __forceinline__ void tr_item(const float* src, int lds_, int n0s, int k0, const float* gain, bf16* dst, int ldd, int n0d, int kd0, LAS float* scr, int lane) {
#pragma unroll 8
    for (int i = 0; i < 32; ++i) { const int kk = 2 * i + (lane >> 5); float v = src[(size_t)(k0 + kk) * lds_ + n0s + (lane & 31)]; if (gain) v *= gain[k0 + kk]; scr[kk * 33 + (lane & 31)] = v; }
    tr_store(scr, dst, ldd, n0d, kd0, lane);
}
__device__ __forceinline__ void wp_item(const float* pp, const float* ps, const float* wbp, int k0, int n0, bf16* dst, int ldd, int kd0, LAS float* scr, int lane) {
    const int g = k0 >> 7, c0 = (k0 & 127) + 32 * (lane >> 5), n = n0 + (lane & 31);
    float acc[32];
#pragma unroll
    for (int i = 0; i < 32; ++i) acc[i] = 0.f;
    const float* ppg = pp + (size_t)g * 128 * 128 + (size_t)c0 * 128;
    for (int d = 0; d < 128; ++d) { const float x = ps[g * 128 + d] * wbp[(size_t)(g * 128 + d) * D + n];
#pragma unroll
        for (int i = 0; i < 32; ++i) acc[i] += ppg[i * 128 + d] * x; }
#pragma unroll
    for (int i = 0; i < 32; ++i) scr[(32 * (lane >> 5) + i) * 33 + (lane & 31)] = acc[i];
    tr_store(scr, dst, ldd, n0, kd0, lane);
}
__device__ __forceinline__ void phase_prologue(Frame& F) {
    LAS float* scr = (LAS float*)(F.lds + F.wave * 16384);
    const int gw = F.vcu * 8 + F.wave, NGW = F.G * 8;
    constexpr int I_INA = 16 * (NA / 32), I_G = 16 * (NG / 32), I_ZH = 8 * 32, I_ZP = 8 * 32, I_OUT = 16 * 32, I_GU = 16 * (NGU / 32), I_DN = (DFF / 64) * 32;
    constexpr int I_LAYER = I_INA + I_G + I_ZH + I_ZP + I_OUT + I_GU + I_DN;
    for (int it = gw; it < DEPTH * I_LAYER; it += NGW) {
        const int l = it / I_LAYER; int r = it % I_LAYER;
        bf16* W = (bf16*)(F.ws + WS_W + (size_t)l * WL_BYTES);
        if (r < I_INA) { const int nblk = NA / 32, kb = r / nblk, nb = r % nblk;
            tr_item(F.in[4] + (size_t)l * D * INC, INC, 32 * nb, 64 * kb, F.in[2] + l * D, (bf16*)((char*)W + WL_INA), D, 32 * nb, 64 * kb, scr, F.lane); continue; } r -= I_INA;
        if (r < I_G) { const int nblk = NG / 32, kb = r / nblk, nb = r % nblk, n0d = 32 * nb, p = n0d >> 8, j = n0d & 255;
            const int n0s = (j < 128) ? (2560 + 128 * p + j) : (3584 + 128 * p + (j - 128));
            tr_item(F.in[4] + (size_t)l * D * INC, INC, n0s, 64 * kb, F.in[2] + l * D, (bf16*)((char*)W + WL_G), D, n0d, 64 * kb, scr, F.lane); continue; } r -= I_G;
        if (r < I_ZH) { const int kb = r / 32, nb = r % 32;
            tr_item(F.in[7] + (size_t)l * 512 * D, D, 32 * nb, 64 * kb, F.in[6] + l * 512, (bf16*)((char*)W + WL_Z), D, 32 * nb, 64 * kb, scr, F.lane); continue; } r -= I_ZH;
        if (r < I_ZP) { const int kb = r / 32, nb = r % 32;
            wp_item(F.in[8] + (size_t)l * 4 * 128 * 128, F.in[9] + l * 512, F.in[10] + (size_t)l * 512 * D, 64 * kb, 32 * nb, (bf16*)((char*)W + WL_Z), D, 512 + 64 * kb, scr, F.lane); continue; } r -= I_ZP;
        if (r < I_OUT) { const int kb = r / 32, nb = r % 32;
            tr_item(F.in[11] + (size_t)l * D * D, D, 32 * nb, 64 * kb, nullptr, (bf16*)((char*)W + WL_OUT), D, 32 * nb, 64 * kb, scr, F.lane); continue; } r -= I_OUT;
        if (r < I_GU) { const int nblk = NGU / 32, kb = r / nblk, nb = r % nblk, n0d = 32 * nb, p = n0d >> 8, j = n0d & 255;
            const float* src = (j < 128 ? F.in[14] : F.in[15]) + (size_t)l * D * DFF;
            tr_item(src, DFF, 128 * p + (j & 127), 64 * kb, F.in[12] + l * D, (bf16*)((char*)W + WL_GU), D, n0d, 64 * kb, scr, F.lane); continue; } r -= I_GU;
        { const int kb = r / 32, nb = r % 32;
            tr_item(F.in[18] + (size_t)l * DFF * D, D, 32 * nb, 64 * kb, nullptr, (bf16*)((char*)W + WL_DN), DFF, 32 * nb, 64 * kb, scr, F.lane); }
    }
    bf16* HB = (bf16*)(F.ws + WS_HB); float* RS = (float*)(F.ws + WS_RS);
    for (int r = gw; r < MROWS; r += NGW) {
        f32x4 v[4];
        if (r < MX) {
#pragma unroll
            for (int j = 0; j < 4; ++j) v[j] = *((const f32x4*)(F.in[0] + (size_t)r * D) + F.lane + 64 * j);
        } else if (r < MX + NMETA) {
#pragma unroll
            for (int j = 0; j < 4; ++j) v[j] = *((const f32x4*)(F.in[1] + (size_t)(r - MX) * D) + F.lane + 64 * j);
        } else {
#pragma unroll
            for (int j = 0; j < 4; ++j) v[j] = (f32x4){0.f, 0.f, 0.f, 0.f};
        }
        float ss = 0.f;
#pragma unroll
        for (int j = 0; j < 4; ++j) ss += (v[j].x * v[j].x + v[j].y * v[j].y) + (v[j].z * v[j].z + v[j].w * v[j].w);
        ss = wave_sum(ss);
        float* hp = hrow_ptr(F, r);
#pragma unroll
        for (int j = 0; j < 4; ++j) { *((f32x4*)hp + F.lane + 64 * j) = v[j];
            u32x2 w; w.x = pk2(v[j].x, v[j].y); w.y = pk2(v[j].z, v[j].w); *((u32x2*)(HB + (size_t)r * D) + F.lane + 64 * j) = w; }
        if (F.lane == 0) RS[r] = 1.0f / sqrtf(ss * (1.0f / D) + EPS);
    }
    if (blockIdx.x == 0) { float* LB = (float*)(F.ws + WS_LB);
        for (int k = F.tid; k < 512; k += 512) { const float x0 = F.in[5][k], x1 = F.in[5][512 + k]; const float mx = fmaxf(x0, x1), e0 = __expf(x0 - mx), e1 = __expf(x1 - mx);
            const float g0 = e0 / (e0 + e1), g1 = e1 / (e0 + e1); float lb1 = (g0 + g1) - g0; lb1 = fminf(fmaxf(lb1, 0.f), 1.f); LB[k] = 0.f; LB[512 + k] = lb1; } }
}

namespace hg {
constexpr int SQ = 136, S72 = 72;
constexpr int L_QS = 0, L_QD = L_QS + 64 * SQ * 2, L_KS = L_QD + 64 * SQ * 2, L_KDT = L_KS + 64 * SQ * 2, L_VT = L_KDT + 128 * S72 * 2, L_P = L_VT + 128 * S72 * 2,
              L_ST = L_P + 64 * S72 * 2, L_CP = L_ST + 128 * SQ * 2, L_DL = L_CP + 8 * 128 * 4, L_RSS = L_DL + 128 * 4, L_END = L_RSS + 2 * 64 * 4;
static_assert(L_END <= MISC_OFF, "hgrn LDS");
__device__ __forceinline__ f32x4 mfma16(bf16x8 a, bf16x8 b, f32x4 c) { return __builtin_amdgcn_mfma_f32_16x16x32_bf16(a, b, c, 0, 0, 0); }

template <bool OUT>
__device__ __forceinline__ void chunk(LAS unsigned char* lds, const bf16* PA, bf16* AP, int r0, int h, int nvalid, const float* lbh, f32x4 (&Sacc)[8], float& dsum0, float& dsum1, int tid) {
    const int w = __builtin_amdgcn_readfirstlane(tid >> 6), lane = tid & 63, fr = lane & 15, fq = lane >> 4;
    LAS bf16* QS = (LAS bf16*)(lds + L_QS); LAS bf16* QD = (LAS bf16*)(lds + L_QD); LAS bf16* KS = (LAS bf16*)(lds + L_KS);
    LAS bf16* KDT = (LAS bf16*)(lds + L_KDT); LAS bf16* VT = (LAS bf16*)(lds + L_VT); LAS bf16* P = (LAS bf16*)(lds + L_P); LAS bf16* ST = (LAS bf16*)(lds + L_ST);
    LAS float* CP = (LAS float*)(lds + L_CP); LAS float* DL = (LAS float*)(lds + L_DL); LAS float* RSS = (LAS float*)(lds + L_RSS);
    const int k0 = 2 * lane;
    const float lb0 = lbh[k0], lb1 = lbh[k0 + 1];
    float c0[8], c1[8], kk0[8], kk1[8], q0[8], q1[8];
    float run0 = 0.f, run1 = 0.f;
#pragma unroll
    for (int j = 0; j < 8; ++j) { const int t = 8 * w + j; const bool valid = t < nvalid;
        unsigned fw = 0u, qw = 0u;
        if (valid) { const bf16* rowp = PA + (size_t)(r0 + t) * NA + h * 128 + k0; qw = *(const unsigned*)rowp; fw = *(const unsigned*)(rowp + 512); }
        const float f0 = bflo(fw), f1 = bfhi(fw);
        { const float e = __expf(-fabsf(f0)), sp = 1.0f / (1.0f + e), sn = e * sp; const float sg = f0 >= 0.f ? sp : sn, sgn = f0 >= 0.f ? sn : sp;
          const float f = lb0 + (1.0f - lb0) * sg; float lf = __logf(fmaxf(f, 1e-30f)); float kk = (1.0f - lb0) * sgn; if (!valid) { lf = 0.f; kk = 0.f; }
          run0 += lf; c0[j] = run0; kk0[j] = kk; q0[j] = bflo(qw); }
        { const float e = __expf(-fabsf(f1)), sp = 1.0f / (1.0f + e), sn = e * sp; const float sg = f1 >= 0.f ? sp : sn, sgn = f1 >= 0.f ? sn : sp;
          const float f = lb1 + (1.0f - lb1) * sg; float lf = __logf(fmaxf(f, 1e-30f)); float kk = (1.0f - lb1) * sgn; if (!valid) { lf = 0.f; kk = 0.f; }
          run1 += lf; c1[j] = run1; kk1[j] = kk; q1[j] = bfhi(qw); }
    }
    CP[w * 128 + k0] = run0; CP[w * 128 + k0 + 1] = run1;
    u32x4 va = (u32x4){0u, 0u, 0u, 0u}, vb = va;
    if (lane < nvalid) { const bf16* vp = PA + (size_t)(r0 + lane) * NA + 1024 + h * 128 + 16 * w; va = *(const u32x4*)vp; vb = *(const u32x4*)(vp + 8); }
    __syncthreads();
    float pre0 = 0.f, pre1 = 0.f, tot0 = 0.f, tot1 = 0.f, mid0 = 0.f, mid1 = 0.f;
#pragma unroll
    for (int ww = 0; ww < 8; ++ww) { const float x0 = CP[ww * 128 + k0], x1 = CP[ww * 128 + k0 + 1];
        if (ww < w) { pre0 += x0; pre1 += x1; } if (ww < 4) { mid0 += x0; mid1 += x1; } tot0 += x0; tot1 += x1; }
    {
        unsigned kd0[4], kd1[4];
#pragma unroll
        for (int j = 0; j < 8; ++j) { const int t = 8 * w + j;
            const float b0 = pre0 + c0[j], b1 = pre1 + c1[j];
            const float qd0 = q0[j] * __expf(b0), qd1 = q1[j] * __expf(b1);
            const float qs0 = q0[j] * __expf(fminf(b0 - mid0, 80.f)), qs1 = q1[j] * __expf(fminf(b1 - mid1, 80.f));
            const float ks0 = kk0[j] * __expf(fminf(mid0 - b0, 80.f)), ks1 = kk1[j] * __expf(fminf(mid1 - b1, 80.f));
            const float kdv0 = kk0[j] * __expf(tot0 - b0), kdv1 = kk1[j] * __expf(tot1 - b1);
            *(LAS unsigned*)(QD + t * SQ + k0) = pk2(qd0, qd1);
            *(LAS unsigned*)(QS + t * SQ + k0) = pk2(qs0, qs1);
            *(LAS unsigned*)(KS + t * SQ + k0) = pk2(ks0, ks1);
            if (j & 1) { kd0[j >> 1] |= f2bf(kdv0) << 16; kd1[j >> 1] |= f2bf(kdv1) << 16; } else { kd0[j >> 1] = f2bf(kdv0); kd1[j >> 1] = f2bf(kdv1); }
        }
        *(LAS u32x4*)(KDT + k0 * S72 + 8 * w) = (u32x4){kd0[0], kd0[1], kd0[2], kd0[3]};
        *(LAS u32x4*)(KDT + (k0 + 1) * S72 + 8 * w) = (u32x4){kd1[0], kd1[1], kd1[2], kd1[3]};
    }
    if (w == 0) { DL[k0] = __expf(tot0); DL[k0 + 1] = __expf(tot1); dsum0 += tot0; dsum1 += tot1; }
    {
        const unsigned vv[8] = {va.x, va.y, va.z, va.w, vb.x, vb.y, vb.z, vb.w};
#pragma unroll
        for (int j = 0; j < 8; ++j) { VT[(16 * w + 2 * j) * S72 + lane] = (bf16)(vv[j] & 0xffffu); VT[(16 * w + 2 * j + 1) * S72 + lane] = (bf16)(vv[j] >> 16); }
    }
    if (OUT) {
#pragma unroll
        for (int cb = 0; cb < 8; ++cb) { u32x2 wv; wv.x = pk2(Sacc[cb][0], Sacc[cb][1]); wv.y = pk2(Sacc[cb][2], Sacc[cb][3]);
            *(LAS u32x2*)(ST + (cb * 16 + fr) * SQ + 16 * w + 4 * fq) = wv; }
    }
    __syncthreads();
    if (OUT) {
        const int tb = w >> 1;
#pragma unroll
        for (int blk = 0; blk < 2; ++blk) { const int sb = 2 * (w & 1) + blk; f32x4 acc = (f32x4){0.f, 0.f, 0.f, 0.f};
            if (sb <= tb) {
#pragma unroll
                for (int ks = 0; ks < 4; ++ks) { const bf16x8 a = *(const LAS bf16x8*)(KS + (sb * 16 + fr) * SQ + ks * 32 + 8 * fq); const bf16x8 b = *(const LAS bf16x8*)(QS + (tb * 16 + fr) * SQ + ks * 32 + 8 * fq);
                    acc = mfma16(a, b, acc); } }
            const int t = tb * 16 + fr, s0 = sb * 16 + 4 * fq;
            u32x2 wv; wv.x = pk2(s0 + 0 <= t ? acc[0] : 0.f, s0 + 1 <= t ? acc[1] : 0.f); wv.y = pk2(s0 + 2 <= t ? acc[2] : 0.f, s0 + 3 <= t ? acc[3] : 0.f);
            *(LAS u32x2*)(P + t * S72 + s0) = wv; }
    }
    f32x4 oacc[4];
    {
        const f32x4 dl = *(const LAS f32x4*)(DL + 16 * w + 4 * fq);
        bf16x8 a[2];
#pragma unroll
        for (int ks = 0; ks < 2; ++ks) a[ks] = *(const LAS bf16x8*)(KDT + (16 * w + fr) * S72 + ks * 32 + 8 * fq);
#pragma unroll
        for (int cb = 0; cb < 8; ++cb) { f32x4 s = Sacc[cb] * dl;
#pragma unroll
            for (int ks = 0; ks < 2; ++ks) { const bf16x8 b = *(const LAS bf16x8*)(VT + (cb * 16 + fr) * S72 + ks * 32 + 8 * fq); s = mfma16(a[ks], b, s); }
            Sacc[cb] = s; }
    }
    if (OUT) {
        __syncthreads();
        const int tb = w & 3, ch = w >> 2;
#pragma unroll
        for (int i = 0; i < 4; ++i) oacc[i] = (f32x4){0.f, 0.f, 0.f, 0.f};
#pragma unroll
        for (int ks = 0; ks < 2; ++ks) { const bf16x8 b = *(const LAS bf16x8*)(P + (tb * 16 + fr) * S72 + ks * 32 + 8 * fq);
#pragma unroll
            for (int i = 0; i < 4; ++i) { const bf16x8 a = *(const LAS bf16x8*)(VT + ((ch * 4 + i) * 16 + fr) * S72 + ks * 32 + 8 * fq); oacc[i] = mfma16(a, b, oacc[i]); } }
#pragma unroll
        for (int ks = 0; ks < 4; ++ks) { const bf16x8 b = *(const LAS bf16x8*)(QD + (tb * 16 + fr) * SQ + ks * 32 + 8 * fq);
#pragma unroll
            for (int i = 0; i < 4; ++i) { const bf16x8 a = *(const LAS bf16x8*)(ST + ((ch * 4 + i) * 16 + fr) * SQ + ks * 32 + 8 * fq); oacc[i] = mfma16(a, b, oacc[i]); } }
        float ss = 0.f;
#pragma unroll
        for (int i = 0; i < 4; ++i) ss += (oacc[i][0] * oacc[i][0] + oacc[i][1] * oacc[i][1]) + (oacc[i][2] * oacc[i][2] + oacc[i][3] * oacc[i][3]);
        ss += __shfl_xor(ss, 16); ss += __shfl_xor(ss, 32);
        if (lane < 16) RSS[ch * 64 + tb * 16 + lane] = ss;
        __syncthreads();
        const int t = tb * 16 + fr;
        const float rn = 1.0f / sqrtf((RSS[t] + RSS[64 + t]) * (1.0f / 128.0f) + EPS);
        if (t < nvalid) {
#pragma unroll
            for (int i = 0; i < 4; ++i) { const int c = (ch * 4 + i) * 16 + 4 * fq;
                const u32x2 gw = *(const u32x2*)(PA + (size_t)(r0 + t) * NA + 1536 + h * 128 + c);
                u32x2 wv; wv.x = pk2(oacc[i][0] * rn * bflo(gw.x), oacc[i][1] * rn * bfhi(gw.x)); wv.y = pk2(oacc[i][2] * rn * bflo(gw.y), oacc[i][3] * rn * bfhi(gw.y));
                *(u32x2*)(AP + (size_t)(r0 + t) * D + h * 128 + c) = wv; }
        }
    }
}
}

__device__ __forceinline__ void phase_pool(Frame& F, const bf16* PA, bf16* AP) {
    for (int it = F.vcu; it < 513 * 4; it += F.G) {
        const int rb = it >> 2, g = it & 3, wn = 2 << g, c = g * 128 + 2 * F.lane;
#pragma unroll 1
        for (int j = 0; j < 8; ++j) { const int r = rb * 64 + 8 * F.wave + j;
            if (r >= META0 + NMETA) continue;
            float s0 = 0.f, s1 = 0.f, v0 = 0.f, v1 = 0.f; int cnt = 0;
            for (int jj = 0; jj < wn; ++jj) { const int pr = prev_row(r, jj); if (pr < 0) break;
                const unsigned wv = *(const unsigned*)(PA + (size_t)pr * NA + 2048 + c); const float a0 = bflo(wv), a1 = bfhi(wv);
                if (jj == 0) { v0 = a0; v1 = a1; } s0 += a0; s1 += a1; ++cnt; }
            const float ic = 1.0f / (float)cnt;
            *(unsigned*)(AP + (size_t)r * D + 512 + c) = pk2(s0 * ic - v0, s1 * ic - v1); }
    }
}

__device__ __forceinline__ void hgrn_store_state(float* dst, const f32x4 (&Sacc)[8], int tid) {
#pragma unroll
    for (int cb = 0; cb < 8; ++cb)
#pragma unroll
        for (int i = 0; i < 4; ++i) dst[(cb * 4 + i) * 512 + tid] = Sacc[cb][i];
}
__device__ __forceinline__ void phase_hgrn_a(Frame& F, int l, const bf16* PA, bf16* AP) {
    unsigned char* big = F.ws + WS_BIG;
    const float* LB = (const float*)(F.ws + WS_LB) + l * 512;
    f32x4 Sacc[8];
    if (F.vcu < 4) {
        const int h = F.vcu; float d0 = 0.f, d1 = 0.f;
#pragma unroll
        for (int cb = 0; cb < 8; ++cb) Sacc[cb] = (f32x4){0.f, 0.f, 0.f, 0.f};
        hg::chunk<true>(F.lds, PA, AP, META0, h, NMETA, LB + h * 128, Sacc, d0, d1, F.tid);
        hgrn_store_state((float*)(big + B_SM) + (size_t)h * 16384, Sacc, F.tid);
        __syncthreads();
    }
    for (int u = F.vcu; u < 256; u += F.G) {
        const int b = u >> 6, h = (u >> 4) & 3, j = u & 15; float d0 = 0.f, d1 = 0.f;
#pragma unroll
        for (int cb = 0; cb < 8; ++cb) Sacc[cb] = (f32x4){0.f, 0.f, 0.f, 0.f};
        for (int i = 0; i < 8; ++i) hg::chunk<false>(F.lds, PA, AP, b * SEQ + 64 * (8 * j + i), h, 64, LB + h * 128, Sacc, d0, d1, F.tid);
        hgrn_store_state((float*)(big + B_KV) + (size_t)u * 16384, Sacc, F.tid);
        if (F.wave == 0) { float* DD = (float*)(big + B_DD) + u * 128; DD[2 * F.lane] = __expf(d0); DD[2 * F.lane + 1] = __expf(d1); }
        __syncthreads();
    }
}
__device__ __forceinline__ void phase_hgrn_b(Frame& F) {
    unsigned char* big = F.ws + WS_BIG;
    const float* KV = (const float*)(big + B_KV); float* SS = (float*)(big + B_SS); const float* SM = (const float*)(big + B_SM); const float* DD = (const float*)(big + B_DD);
    for (int g = F.vcu * 512 + F.tid; g < 16 * 16384; g += F.G * 512) {
        const int bh = g >> 14, e = g & 16383, h = bh & 3, tidx = e & 511, reg = e >> 9;
        const int k = 16 * (tidx >> 6) + 4 * ((tidx & 63) >> 4) + (reg & 3);
        float s = SM[(size_t)h * 16384 + e];
        for (int j = 0; j < 16; ++j) { const int u = bh * 16 + j; SS[(size_t)u * 16384 + e] = s; s = DD[u * 128 + k] * s + KV[(size_t)u * 16384 + e]; }
    }
}
__device__ __forceinline__ void phase_hgrn_c(Frame& F, int l, const bf16* PA, bf16* AP) {
    unsigned char* big = F.ws + WS_BIG;
    const float* LB = (const float*)(F.ws + WS_LB) + l * 512;
    f32x4 Sacc[8];
    for (int u = F.vcu; u < 256; u += F.G) {
        const int b = u >> 6, h = (u >> 4) & 3, j = u & 15; float d0 = 0.f, d1 = 0.f;
        const float* src = (const float*)(big + B_SS) + (size_t)u * 16384;
#pragma unroll
        for (int cb = 0; cb < 8; ++cb)
#pragma unroll
            for (int i = 0; i < 4; ++i) Sacc[cb][i] = src[(cb * 4 + i) * 512 + F.tid];
        for (int i = 0; i < 8; ++i) hg::chunk<true>(F.lds, PA, AP, b * SEQ + 64 * (8 * j + i), h, 64, LB + h * 128, Sacc, d0, d1, F.tid);
        __syncthreads();
    }
}

__device__ __forceinline__ void phase_ln_res(Frame& F, const float* Y, const float* gain) {
    const int gw = F.vcu * 8 + F.wave, NGW = F.G * 8;
    bf16* HB = (bf16*)(F.ws + WS_HB); float* RS = (float*)(F.ws + WS_RS);
    f32x4 gv[4];
#pragma unroll
    for (int j = 0; j < 4; ++j) gv[j] = *((const f32x4*)gain + F.lane + 64 * j);
    for (int r = gw; r < MROWS; r += NGW) {
        float* hp = hrow_ptr(F, r);
        f32x4 y[4], hv[4]; float ss = 0.f;
#pragma unroll
        for (int j = 0; j < 4; ++j) { y[j] = *((const f32x4*)(Y + (size_t)r * D) + F.lane + 64 * j); hv[j] = *((const f32x4*)hp + F.lane + 64 * j);
            ss += (y[j].x * y[j].x + y[j].y * y[j].y) + (y[j].z * y[j].z + y[j].w * y[j].w); }
        const float rn = 1.0f / sqrtf(wave_sum(ss) * (1.0f / D) + EPS);
        float s2 = 0.f;
#pragma unroll
        for (int j = 0; j < 4; ++j) { hv[j] = hv[j] + y[j] * rn * gv[j]; s2 += (hv[j].x * hv[j].x + hv[j].y * hv[j].y) + (hv[j].z * hv[j].z + hv[j].w * hv[j].w); }
        s2 = wave_sum(s2);
#pragma unroll
        for (int j = 0; j < 4; ++j) { *((f32x4*)hp + F.lane + 64 * j) = hv[j];
            u32x2 w; w.x = pk2(hv[j].x, hv[j].y); w.y = pk2(hv[j].z, hv[j].w); *((u32x2*)(HB + (size_t)r * D) + F.lane + 64 * j) = w; }
        if (F.lane == 0) RS[r] = 1.0f / sqrtf(s2 * (1.0f / D) + EPS);
    }
}

__device__ __forceinline__ float gelu_tanh(float x) {
    const float y = 0.7978845608028654f * (x + 0.044715f * x * x * x);
    const float e = __expf(-2.0f * fabsf(y)); const float th = (1.0f - e) / (1.0f + e);
    return 0.5f * x * (1.0f + (y >= 0.f ? th : -th));
}
__device__ __forceinline__ void phase_conv(Frame& F, int l, const bf16* G, bf16* U) {
    const float* cw = F.in[16] + (size_t)l * 3 * DFF; const float* cb = F.in[17] + (size_t)l * DFF;
    constexpr int CG = DFF / 8;
    for (int idx = F.vcu * 512 + F.tid; idx < MROWS * CG; idx += F.G * 512) {
        const int r = idx / CG, c = (idx % CG) * 8;
        const int r1 = (r < META0 + NMETA) ? prev_row(r, 1) : -1, r2 = (r < META0 + NMETA) ? prev_row(r, 2) : -1;
        const u32x4 z = (u32x4){0u, 0u, 0u, 0u};
        const u32x4 g2 = *(const u32x4*)(G + (size_t)r * DFF + c);
        const u32x4 g1 = r1 >= 0 ? *(const u32x4*)(G + (size_t)r1 * DFF + c) : z;
        const u32x4 g0 = r2 >= 0 ? *(const u32x4*)(G + (size_t)r2 * DFF + c) : z;
        const u32x4 uu = *(const u32x4*)(U + (size_t)r * DFF + c);
        const unsigned a0[4] = {g0.x, g0.y, g0.z, g0.w}, a1[4] = {g1.x, g1.y, g1.z, g1.w}, a2[4] = {g2.x, g2.y, g2.z, g2.w}, au[4] = {uu.x, uu.y, uu.z, uu.w};
        unsigned o[4];
#pragma unroll
        for (int e = 0; e < 4; ++e) { const int cc = c + 2 * e;
            const float x0 = cb[cc] + cw[cc] * bflo(a0[e]) + cw[DFF + cc] * bflo(a1[e]) + cw[2 * DFF + cc] * bflo(a2[e]);
            const float x1 = cb[cc + 1] + cw[cc + 1] * bfhi(a0[e]) + cw[DFF + cc + 1] * bfhi(a1[e]) + cw[2 * DFF + cc + 1] * bfhi(a2[e]);
            o[e] = pk2(gelu_tanh(x0) * bflo(au[e]), gelu_tanh(x1) * bfhi(au[e])); }
        *(u32x4*)(U + (size_t)r * DFF + c) = (u32x4){o[0], o[1], o[2], o[3]};
    }
}

struct Args { const float* in[19]; float* out; unsigned char* ws; int ph_lo, ph_hi, li, pad; };
constexpr int PH_PER_LAYER = 12, N_PHASES = 1 + DEPTH * PH_PER_LAYER;

__global__ void __launch_bounds__(512, 2) trunk_fwd(Args args) {
    extern __shared__ __attribute__((aligned(16))) unsigned char lds_raw[];
    Frame F;
    F.lds = (LAS unsigned char*)lds_raw;
    F.tid = threadIdx.x; F.lane = F.tid & 63; F.wave = __builtin_amdgcn_readfirstlane(F.tid >> 6);
    F.G = gridDim.x; { const int bx = blockIdx.x; F.vcu = (F.G % 8 == 0) ? (bx % 8) * (F.G / 8) + bx / 8 : bx; }
#pragma unroll
    for (int i = 0; i < 19; ++i) F.in[i] = args.in[i];
    F.out = args.out; F.ws = args.ws;
    volatile LAS unsigned* MISC = (volatile LAS unsigned*)(F.lds + MISC_OFF);
    if (F.tid < 64) MISC[F.tid] = 0u;
    __syncthreads();
#if MK_ONE_LAUNCH
    XcdBarrier bar = xcd_barrier_post((unsigned*)(F.ws + WS_CTL) + CW_BAR, MISC + 8);
#define GRID_BAR() xcd_barrier(bar)
#else
#define GRID_BAR() do {} while (0)
#endif
    const int lo = args.ph_lo, hi = args.ph_hi;
    unsigned char* big = F.ws + WS_BIG;
    bf16* HB = (bf16*)(F.ws + WS_HB); const float* RS = (const float*)(F.ws + WS_RS);
    int ph = 0;
#ifndef MK_ONLY
#define MK_ONLY -1
#endif
    constexpr int cbase = __COUNTER__ + 1;
#define PHASE(...) do { constexpr int pid_ = __COUNTER__ - cbase; if constexpr (MK_ONLY < 0 || MK_ONLY == pid_) { if (lo <= ph && ph < hi) { { int t_ = threadIdx.x; asm volatile("" : "+v"(t_)); F.tid = t_; F.lane = t_ & 63; F.wave = __builtin_amdgcn_readfirstlane(t_ >> 6); } __VA_ARGS__; if (ph + 1 < hi) GRID_BAR(); } } ++ph; } while (0)

    PHASE(phase_prologue(F));
    for (int l = 0; l < DEPTH; ++l) {
        const bf16* W = (const bf16*)(F.ws + WS_W + (size_t)l * WL_BYTES);
        bf16* PA = (bf16*)(big + B_PA); bf16* AP = (bf16*)(big + B_AP); bf16* Z = (bf16*)(big + B_Z); bf16* GT = (bf16*)(big + B_PA); float* Y1 = (float*)(big + B_PA);
        bf16* Gb = (bf16*)(big + B_G); bf16* Ub = (bf16*)(big + B_U); float* Y2 = (float*)(big + B_G);
        PHASE({ pg8::Gemm g{HB, (const bf16*)((const char*)W + WL_INA), D, D, D, 0}; pg8::StaticOrder S; S.init(MROWS, NA, F.G, (int)blockIdx.x);
                pg8::EpiProjA E{PA, RS}; pg8::gemm_phase<pg8::EpiProjA, pg8::StaticOrder, true>(F.lds, g, S, E, F.tid); });
        PHASE({ phase_pool(F, PA, AP); phase_hgrn_a(F, l, PA, AP); });
        PHASE(phase_hgrn_b(F));
        PHASE(phase_hgrn_c(F, l, PA, AP));
        PHASE({ pg8::Gemm g{HB, (const bf16*)((const char*)W + WL_G), D, D, D, 0}; pg8::StaticOrder S; S.init(MROWS, NG, F.G, (int)blockIdx.x);
                pg8::EpiGates E{GT, RS}; pg8::gemm_phase<pg8::EpiGates, pg8::StaticOrder, true>(F.lds, g, S, E, F.tid); });
        PHASE({ pg8::Gemm g{AP, (const bf16*)((const char*)W + WL_Z), D, D, 512, 512}; pg8::PairOrder S; S.init(MROWS, D, F.G, (int)blockIdx.x);
                pg8::EpiZ E{GT, Z}; pg8::gemm_phase<pg8::EpiZ, pg8::PairOrder, true>(F.lds, g, S, E, F.tid); });
        PHASE({ pg8::Gemm g{Z, (const bf16*)((const char*)W + WL_OUT), D, D, D, 0}; pg8::StaticOrder S; S.init(MROWS, D, F.G, (int)blockIdx.x);
                pg8::EpiF32 E{Y1, D}; pg8::gemm_phase<pg8::EpiF32, pg8::StaticOrder, true>(F.lds, g, S, E, F.tid); });
        PHASE(phase_ln_res(F, Y1, F.in[3] + l * D));
        PHASE({ pg8::Gemm g{HB, (const bf16*)((const char*)W + WL_GU), D, D, D, 0}; pg8::StaticOrder S; S.init(MROWS, NGU, F.G, (int)blockIdx.x);
                pg8::EpiGU E{Gb, Ub, RS}; pg8::gemm_phase<pg8::EpiGU, pg8::StaticOrder, true>(F.lds, g, S, E, F.tid); });
        PHASE(phase_conv(F, l, Gb, Ub));
        PHASE({ pg8::Gemm g{Ub, (const bf16*)((const char*)W + WL_DN), DFF, DFF, DFF, 0}; pg8::StaticOrder S; S.init(MROWS, D, F.G, (int)blockIdx.x);
                pg8::EpiF32 E{Y2, D}; pg8::gemm_phase<pg8::EpiF32, pg8::StaticOrder, true>(F.lds, g, S, E, F.tid); });
        PHASE(phase_ln_res(F, Y2, F.in[13] + l * D));
    }
}

extern "C" void kernel_launch(void* const* d_in, const int* in_sizes, int n_in, void* d_out, int out_size, void* d_ws, size_t ws_size, hipStream_t stream) {
    static int grid = 0;
    if (grid == 0) {
        if (n_in != 19 || out_size != MX * D || ws_size < WS_END) { fprintf(stderr, "kernel_launch: unexpected problem (n_in %d out %d ws %zu, need %zu)\n", n_in, out_size, ws_size, (size_t)WS_END); grid = -1; return; }
        int dev = 0, cus = 0;
        if (hipGetDevice(&dev) != hipSuccess || hipDeviceGetAttribute(&cus, hipDeviceAttributeMultiprocessorCount, dev) != hipSuccess) { grid = -1; return; }
        if (hipFuncSetAttribute((const void*)trunk_fwd, hipFuncAttributeMaxDynamicSharedMemorySize, LDS_BYTES) != hipSuccess) { fprintf(stderr, "kernel_launch: hipFuncSetAttribute failed\n"); grid = -1; return; }
        (void)hipGetLastError();
        grid = cus;
    }
    if (grid < 0) return;
    (void)hipMemsetAsync((char*)d_ws + WS_CTL, 0, CTL_BYTES, stream);
    Args a{};
    for (int i = 0; i < 19; ++i) a.in[i] = (const float*)d_in[i];
    a.out = (float*)d_out; a.ws = (unsigned char*)d_ws;
#if MK_ONE_LAUNCH
    a.ph_lo = 0; a.ph_hi = N_PHASES; a.li = 0;
    hipLaunchKernelGGL(trunk_fwd, dim3(grid), dim3(512), LDS_BYTES, stream, a);
#else
    for (int p = 0; p < N_PHASES; ++p) { a.ph_lo = p; a.ph_hi = p + 1; a.li = p; hipLaunchKernelGGL(trunk_fwd, dim3(grid), dim3(512), LDS_BYTES, stream, a); }
#endif
}
```

```cpp
#include <hip/hip_runtime.h>
#include <cstdio>
#include <cstdint>

#ifndef MK_ONE_LAUNCH
#define MK_ONE_LAUNCH 1
#endif

#define LAS __attribute__((address_space(3)))
#define GAS __attribute__((address_space(1)))
typedef unsigned short bf16;
typedef short bf16x8 __attribute__((ext_vector_type(8)));
typedef float f32x4 __attribute__((ext_vector_type(4)));
typedef float f32x2 __attribute__((ext_vector_type(2)));
typedef unsigned u32x4 __attribute__((ext_vector_type(4)));
typedef unsigned u32x2 __attribute__((ext_vector_type(2)));

constexpr int NB = 4, SEQ = 8192, D = 1024, NMETA = 16, DEPTH = 2;
constexpr int MX = NB * SEQ;
constexpr int MROWS = MX + 256;
constexpr int META0 = MX;
constexpr int DFF = 2816, INC = 4608;
constexpr int NA = 2560;
constexpr int NG = 2048;
constexpr int NGU = 2 * DFF;
constexpr float EPS = 1e-6f;

constexpr size_t A256(size_t x) { return (x + 255) & ~(size_t)255; }
constexpr size_t WS_CTL = 0, CTL_BYTES = 1u << 20;
constexpr size_t WL_INA = 0, WL_G = WL_INA + (size_t)NA * D * 2, WL_Z = WL_G + (size_t)NG * D * 2, WL_OUT = WL_Z + (size_t)D * D * 2,
                 WL_GU = WL_OUT + (size_t)D * D * 2, WL_DN = WL_GU + (size_t)NGU * D * 2, WL_BYTES = WL_DN + (size_t)D * DFF * 2;
constexpr size_t WS_W = CTL_BYTES;
constexpr size_t WS_LB = A256(WS_W + DEPTH * WL_BYTES);
constexpr size_t WS_HB = A256(WS_LB + 2 * 512 * 4);
constexpr size_t WS_HM = A256(WS_HB + (size_t)MROWS * D * 2);
constexpr size_t WS_RS = A256(WS_HM + (size_t)256 * D * 4);
constexpr size_t WS_BIG = A256(WS_RS + (size_t)MROWS * 4);
constexpr size_t B_PA = 0;
constexpr size_t B_AP = A256(B_PA + (size_t)MROWS * NA * 2);
constexpr size_t B_Z = A256(B_AP + (size_t)MROWS * D * 2);
constexpr size_t B_KV = A256(B_Z + (size_t)MROWS * D * 2);
constexpr size_t B_SS = B_KV + (size_t)256 * 16384 * 4;
constexpr size_t B_SM = B_SS + (size_t)256 * 16384 * 4;
constexpr size_t B_DD = B_SM + (size_t)4 * 16384 * 4;
constexpr size_t B_MIX_END = B_DD + (size_t)256 * 128 * 4;
constexpr size_t B_G = 0;
constexpr size_t B_U = A256(B_G + (size_t)MROWS * DFF * 2);
constexpr size_t B_FFN_END = B_U + (size_t)MROWS * DFF * 2;
constexpr size_t BIG_BYTES = B_FFN_END > B_MIX_END ? B_FFN_END : B_MIX_END;
constexpr size_t WS_END = WS_BIG + BIG_BYTES;
static_assert((size_t)MROWS * D * 4 <= (size_t)MROWS * NA * 2 && (size_t)MROWS * NG * 2 <= (size_t)MROWS * NA * 2, "Y1 / gates overlay proj_a");
static_assert((size_t)MROWS * D * 4 <= (size_t)MROWS * DFF * 2, "Y2 overlays G");
static_assert(WS_END <= 536870912ull, "d_ws map exceeds 512 MiB");

constexpr int CW_TMO = 0;
constexpr int CW_BAR = 4096;

constexpr int LDS_BYTES = 147456;
constexpr int MISC_OFF = LDS_BYTES - 256;

__device__ __forceinline__ unsigned f2bf(float f) { unsigned u = __builtin_bit_cast(unsigned, f); return (u + 0x7fffu + ((u >> 16) & 1u)) >> 16; }
__device__ __forceinline__ unsigned pk2(float lo, float hi) { return f2bf(lo) | (f2bf(hi) << 16); }
__device__ __forceinline__ float bflo(unsigned w) { return __builtin_bit_cast(float, w << 16); }
__device__ __forceinline__ float bfhi(unsigned w) { return __builtin_bit_cast(float, w & 0xffff0000u); }
__device__ __forceinline__ float fsigmoid(float x) { return 1.0f / (1.0f + __expf(-x)); }
__device__ __forceinline__ float wave_sum(float v) {
#pragma unroll
    for (int o = 1; o < 64; o <<= 1) v += __shfl_xor(v, o);
    return v;
}
#define LDS_WAIT() asm volatile("s_waitcnt lgkmcnt(0)" ::: "memory")
#define VM_WAIT() asm volatile("s_waitcnt vmcnt(0)" ::: "memory")

namespace pg8 {
#define PG8_LAS __attribute__((address_space(3)))
typedef unsigned short bf16_t;
constexpr int BM = 256, BK = 64, HALF = 128, HTB = HALF * BK * 2, STAGE_BYTES = 8 * HTB, NXCD = 8, WGM = 8;
__host__ __device__ __forceinline__ int lds_byte(int r, int c) { const int st = (r >> 4) * 2 + (c >> 5), rr = r & 15, cc = c & 31, ob = rr * 64 + cc * 2; return st * 1024 + (ob ^ (((ob >> 9) & 1) << 5)); }
__host__ __device__ __forceinline__ void stage_rc(int b, int& R, int& C) { const int st = b / 1024, sb = b % 1024, swz = sb ^ (((sb >> 9) & 1) << 5); R = (st >> 1) * 16 + swz / 64; C = (st & 1) * 32 + (swz % 64) / 2; }
__host__ __device__ __forceinline__ int perm32(int rho) { const int n = rho >> 4, i = rho & 15; return 8 * (i >> 2) + 4 * n + (i & 3); }

struct Unit { int pm, pn, half; };
struct Gemm { const bf16_t* A; const bf16_t* Bt; int lda, ldb, K, khalf; };

struct StaticOrder {
    int nM, nN, nwg, G, c;
    __host__ __device__ void init(int M, int N, int G_, int c_) { nM = M / BM; nN = N / BM; nwg = nM * nN; G = G_; c = c_; }
    __host__ __device__ bool tile(int i, Unit& u) const {
        const long L = (long)i * G + c; if (L >= nwg) return false;
        int wgid = (int)L; { const int q = nwg / NXCD, r = nwg % NXCD, xcd = wgid % NXCD, off = wgid / NXCD; wgid = (xcd < r ? xcd * (q + 1) : r * (q + 1) + (xcd - r) * q) + off; }
        const int nig = WGM * nN, gid = wgid / nig, fm = gid * WGM, gsz = (nM - fm) < WGM ? (nM - fm) : WGM;
        u.pm = fm + ((wgid % nig) % gsz); u.pn = (wgid % nig) / gsz; u.half = 0; return true;
    }
    __host__ __device__ bool next(int i, Unit& u) const { return tile(i, u); }
};
struct PairOrder : StaticOrder {
    __host__ __device__ bool next(int i, Unit& u) const { if (!tile(i >> 1, u)) return false; u.half = i & 1; return true; }
};

__device__ __forceinline__ unsigned cvt_pk_bf16(float lo, float hi) { unsigned r; asm volatile("v_cvt_pk_bf16_f32 %0, %1, %2" : "=v"(r) : "v"(lo), "v"(hi)); return r; }

typedef f32x4 Acc[2][2][4][2];

template <class Epi, class Sched, bool ALIGN_EPI>
__device__ __forceinline__ void gemm_phase(PG8_LAS unsigned char* lds, const Gemm g, const Sched& S, const Epi& E, const int tid) {
    const int wid = __builtin_amdgcn_readfirstlane(tid >> 6), lane = tid & 63, wr = wid >> 2, wc = wid & 3, fr = lane & 15, fq = lane >> 4;
    const int nt = g.K / BK;
    unsigned voffA[2], voffB[2];
#pragma unroll
    for (int i = 0; i < 2; ++i) { int R, C; stage_rc(tid * 16 + i * 8192, R, C); const int Rb = Epi::PERM ? ((R & ~31) + perm32(R & 31)) : R;
        voffA[i] = (unsigned)(R * g.lda + C) * 2u; voffB[i] = (unsigned)(Rb * g.ldb + C) * 2u; }
    const size_t kstep = (size_t)(BK * 2);
    const size_t hstepA = (size_t)HALF * g.lda * 2, hstepB = (size_t)HALF * g.ldb * 2;
    const unsigned ldsw = (unsigned)wid * 1024u;
    const int aoff = lds_byte(wr * 64 + fr, fq * 8), boff = lds_byte(wc * 32 + fr, fq * 8);
#define PG8_SA(b, h) (((b) * 2 + (h)) * HTB)
#define PG8_SB(b, h) ((4 + (b) * 2 + (h)) * HTB)
#define PG8_STAGE(bufoff, gbase, voff) do { _Pragma("unroll") for (int _i = 0; _i < 2; ++_i) \
        __builtin_amdgcn_global_load_lds((const unsigned*)((const char*)(gbase) + (voff)[_i]), (PG8_LAS unsigned*)(lds + (bufoff) + ldsw + _i * 8192), 16, 0, 0); } while (0)
#define PG8_LDA(dst, b, h) do { _Pragma("unroll") for (int m = 0; m < 4; ++m) _Pragma("unroll") for (int k = 0; k < 2; ++k) dst[m][k] = *(const PG8_LAS bf16x8*)(lds + PG8_SA(b, h) + aoff + m * 2048 + k * 1024); } while (0)
#define PG8_LDB(dst, b, h) do { _Pragma("unroll") for (int n = 0; n < 2; ++n) _Pragma("unroll") for (int k = 0; k < 2; ++k) dst[n][k] = *(const PG8_LAS bf16x8*)(lds + PG8_SB(b, h) + boff + n * 2048 + k * 1024); } while (0)
#define PG8_MMA(ai, bj, At, Bt) do { __builtin_amdgcn_s_setprio(1); _Pragma("unroll") for (int m = 0; m < 4; ++m) _Pragma("unroll") for (int n = 0; n < 2; ++n) _Pragma("unroll") for (int k = 0; k < 2; ++k) \
        acc[ai][bj][m][n] = __builtin_amdgcn_mfma_f32_16x16x32_bf16(Bt[n][k], At[m][k], acc[ai][bj][m][n], 0, 0, 0); __builtin_amdgcn_s_setprio(0); } while (0)
#define PG8_WAIT_V(n) asm volatile("s_waitcnt vmcnt(" #n ")" ::: "memory")
#define PG8_WAIT_L(n) asm volatile("s_waitcnt lgkmcnt(" #n ")" ::: "memory")
#define PG8_BAR __builtin_amdgcn_s_barrier()
#define PG8_SCHED __builtin_amdgcn_sched_barrier(0)
#define PG8_UA(u) ((const char*)g.A + (size_t)(u).pm * 2 * hstepA + (size_t)(u).half * g.khalf * 2)
#define PG8_UB(u) ((const char*)g.Bt + (size_t)(u).pn * 2 * hstepB + (size_t)(u).half * g.khalf * 2)
    Unit cur, nxt; int ui = 0;
    if (!S.next(0, cur)) return;
    Acc acc;
#pragma unroll
    for (int a = 0; a < 2; ++a)
#pragma unroll
        for (int b = 0; b < 2; ++b)
#pragma unroll
            for (int m = 0; m < 4; ++m)
#pragma unroll
                for (int n = 0; n < 2; ++n) acc[a][b][m][n] = (f32x4){0.f, 0.f, 0.f, 0.f};
    bf16x8 At[4][2], B0[2][2], B1[2][2];
    const char* cA = PG8_UA(cur); const char* cB = PG8_UB(cur);
    PG8_STAGE(PG8_SB(0, 0), cB, voffB); PG8_STAGE(PG8_SB(0, 1), cB + hstepB, voffB); PG8_STAGE(PG8_SA(0, 0), cA, voffA); PG8_STAGE(PG8_SA(0, 1), cA + hstepA, voffA);
    if (wr == 1) PG8_BAR;
    PG8_WAIT_V(2); PG8_BAR;
    PG8_STAGE(PG8_SB(1, 0), cB + kstep, voffB); PG8_STAGE(PG8_SA(1, 0), cA + kstep, voffA); PG8_STAGE(PG8_SB(1, 1), cB + hstepB + kstep, voffB);
    PG8_WAIT_V(6); PG8_BAR;
    for (;;) {
        const bool has_next = S.next(ui + 1, nxt);
        const char* nA = has_next ? PG8_UA(nxt) : cA; const char* nB = has_next ? PG8_UB(nxt) : cB;
        for (int t = 0; t < nt; t += 2) {
            const bool last = (t == nt - 2);
            const char* a1 = cA + (size_t)(t + 1) * kstep;
            const char* a2 = last ? nA : cA + (size_t)(t + 2) * kstep; const char* b2 = last ? nB : cB + (size_t)(t + 2) * kstep;
            const char* a3 = a2 + kstep; const char* b3 = b2 + kstep;
            PG8_LDB(B0, 0, 0); PG8_LDB(B1, 0, 1); PG8_SCHED; PG8_LDA(At, 0, 0); PG8_STAGE(PG8_SA(1, 1), a1 + hstepA, voffA);
            PG8_WAIT_V(8); PG8_WAIT_L(0); PG8_BAR; PG8_MMA(0, 0, At, B0); PG8_MMA(0, 1, At, B1); PG8_BAR; PG8_SCHED;
            PG8_LDA(At, 0, 1); PG8_STAGE(PG8_SB(0, 0), b2, voffB); PG8_STAGE(PG8_SB(0, 1), b2 + hstepB, voffB); PG8_STAGE(PG8_SA(0, 0), a2, voffA);
            PG8_WAIT_V(8); PG8_WAIT_L(0); PG8_BAR; PG8_MMA(1, 0, At, B0); PG8_MMA(1, 1, At, B1); PG8_BAR; PG8_SCHED;
            PG8_LDB(B0, 1, 0); PG8_LDB(B1, 1, 1); PG8_SCHED; PG8_LDA(At, 1, 0); PG8_STAGE(PG8_SA(0, 1), a2 + hstepA, voffA);
            PG8_WAIT_V(8); PG8_WAIT_L(0); PG8_BAR; PG8_MMA(0, 0, At, B0); PG8_MMA(0, 1, At, B1); PG8_BAR; PG8_SCHED;
            PG8_LDA(At, 1, 1); PG8_STAGE(PG8_SB(1, 0), b3, voffB); PG8_STAGE(PG8_SB(1, 1), b3 + hstepB, voffB); PG8_STAGE(PG8_SA(1, 0), a3, voffA);
            PG8_WAIT_V(8); PG8_WAIT_L(0); PG8_BAR; PG8_MMA(1, 0, At, B0); PG8_MMA(1, 1, At, B1); PG8_BAR; PG8_SCHED;
        }
        if constexpr (ALIGN_EPI) { if (wr == 0) PG8_BAR; }
        E(acc, cur, wr, wc, fr, fq);
        if (!has_next) break;
        if (!E.keep(cur)) {
#pragma unroll
            for (int a = 0; a < 2; ++a)
#pragma unroll
                for (int b = 0; b < 2; ++b)
#pragma unroll
                    for (int m = 0; m < 4; ++m)
#pragma unroll
                        for (int n = 0; n < 2; ++n) acc[a][b][m][n] = (f32x4){0.f, 0.f, 0.f, 0.f};
        }
        cur = nxt; cA = nA; cB = nB; ++ui;
        if constexpr (ALIGN_EPI) { if (wr == 1) PG8_BAR; }
    }
    PG8_WAIT_V(0);
    if constexpr (!ALIGN_EPI) { if (wr == 0) PG8_BAR; }
    PG8_BAR;
#undef PG8_SA
#undef PG8_SB
#undef PG8_STAGE
#undef PG8_LDA
#undef PG8_LDB
#undef PG8_MMA
#undef PG8_WAIT_V
#undef PG8_WAIT_L
#undef PG8_BAR
#undef PG8_SCHED
#undef PG8_UA
#undef PG8_UB
}

struct EpiProjA {
    static constexpr bool PERM = true;
    bf16_t* O; const float* rs;
    __device__ __forceinline__ bool keep(const Unit&) const { return false; }
    __device__ __forceinline__ void operator()(Acc& acc, const Unit& u, int wr, int wc, int fr, int fq) const {
        const int row0 = u.pm * BM + wr * 64 + fr, col0 = u.pn * BM + wc * 32 + 8 * fq;
        const bool sig = (u.pn == 6 || u.pn == 7);
#pragma unroll
        for (int ai = 0; ai < 2; ++ai)
#pragma unroll
            for (int m = 0; m < 4; ++m) { const int r = row0 + ai * HALF + m * 16; const float s = rs[r]; bf16_t* rowp = O + (size_t)r * NA + col0;
#pragma unroll
                for (int bj = 0; bj < 2; ++bj) { f32x4 v0 = acc[ai][bj][m][0] * s, v1 = acc[ai][bj][m][1] * s;
                    if (sig) {
#pragma unroll
                        for (int e = 0; e < 4; ++e) { v0[e] = fsigmoid(v0[e]); v1[e] = fsigmoid(v1[e]); } }
                    u32x4 w; w.x = cvt_pk_bf16(v0[0], v0[1]); w.y = cvt_pk_bf16(v0[2], v0[3]); w.z = cvt_pk_bf16(v1[0], v1[1]); w.w = cvt_pk_bf16(v1[2], v1[3]);
                    *(u32x4*)(rowp + bj * HALF) = w; } }
    }
};
struct EpiGates {
    static constexpr bool PERM = true;
    bf16_t* O; const float* rs;
    __device__ __forceinline__ bool keep(const Unit&) const { return false; }
    __device__ __forceinline__ void operator()(Acc& acc, const Unit& u, int wr, int wc, int fr, int fq) const {
        const int row0 = u.pm * BM + wr * 64 + fr, col0 = u.pn * HALF + wc * 32 + 8 * fq;
#pragma unroll
        for (int ai = 0; ai < 2; ++ai)
#pragma unroll
            for (int m = 0; m < 4; ++m) { const int r = row0 + ai * HALF + m * 16; const float s = rs[r]; bf16_t* rowp = O + (size_t)r * NG + col0;
                float R[8], SB[8];
#pragma unroll
                for (int n = 0; n < 2; ++n)
#pragma unroll
                    for (int e = 0; e < 4; ++e) { const float ga = acc[ai][0][m][n][e] * s, gb = acc[ai][1][m][n][e] * s;
                        const float ea = __expf(-ga), eb = __expf(-gb); const float sb = 1.0f / (1.0f + eb);
                        SB[n * 4 + e] = sb; R[n * 4 + e] = (1.0f + eb) / (1.0f + ea); }
                u32x4 w; w.x = cvt_pk_bf16(R[0], R[1]); w.y = cvt_pk_bf16(R[2], R[3]); w.z = cvt_pk_bf16(R[4], R[5]); w.w = cvt_pk_bf16(R[6], R[7]);
                *(u32x4*)(rowp) = w;
                w.x = cvt_pk_bf16(SB[0], SB[1]); w.y = cvt_pk_bf16(SB[2], SB[3]); w.z = cvt_pk_bf16(SB[4], SB[5]); w.w = cvt_pk_bf16(SB[6], SB[7]);
                *(u32x4*)(rowp + 1024) = w; }
    }
};
struct EpiZ {
    static constexpr bool PERM = true;
    const bf16_t* GT; bf16_t* Z;
    __device__ __forceinline__ bool keep(const Unit& u) const { return u.half == 0; }
    __device__ __forceinline__ void operator()(Acc& acc, const Unit& u, int wr, int wc, int fr, int fq) const {
        const int row0 = u.pm * BM + wr * 64 + fr, col0 = u.pn * BM + wc * 32 + 8 * fq;
        const int goff = (u.half == 0) ? 0 : 1024;
#pragma unroll
        for (int ai = 0; ai < 2; ++ai)
#pragma unroll
            for (int m = 0; m < 4; ++m) { const int r = row0 + ai * HALF + m * 16;
#pragma unroll
                for (int bj = 0; bj < 2; ++bj) { const u32x4 gw = *(const u32x4*)(GT + (size_t)r * NG + goff + col0 + bj * HALF);
                    const f32x4 g0 = (f32x4){bflo(gw.x), bfhi(gw.x), bflo(gw.y), bfhi(gw.y)}, g1 = (f32x4){bflo(gw.z), bfhi(gw.z), bflo(gw.w), bfhi(gw.w)};
                    const f32x4 v0 = acc[ai][bj][m][0] * g0, v1 = acc[ai][bj][m][1] * g1;
                    if (u.half == 0) { acc[ai][bj][m][0] = v0; acc[ai][bj][m][1] = v1; }
                    else { u32x4 w; w.x = cvt_pk_bf16(v0[0], v0[1]); w.y = cvt_pk_bf16(v0[2], v0[3]); w.z = cvt_pk_bf16(v1[0], v1[1]); w.w = cvt_pk_bf16(v1[2], v1[3]);
                        *(u32x4*)(Z + (size_t)r * D + col0 + bj * HALF) = w; } } }
    }
};
struct EpiF32 {
    static constexpr bool PERM = false;
    float* C; int ldc;
    __device__ __forceinline__ bool keep(const Unit&) const { return false; }
    __device__ __forceinline__ void operator()(Acc& acc, const Unit& u, int wr, int wc, int fr, int fq) const {
        const int row0 = u.pm * BM + wr * 64 + fr, col0 = u.pn * BM + wc * 32 + 4 * fq;
#pragma unroll
        for (int ai = 0; ai < 2; ++ai)
#pragma unroll
            for (int m = 0; m < 4; ++m) { float* rowp = C + (size_t)(row0 + ai * HALF + m * 16) * ldc + col0;
#pragma unroll
                for (int bj = 0; bj < 2; ++bj)
#pragma unroll
                    for (int n = 0; n < 2; ++n) *(f32x4*)(rowp + bj * HALF + n * 16) = acc[ai][bj][m][n]; }
    }
};
struct EpiGU {
    static constexpr bool PERM = true;
    bf16_t* G; bf16_t* U; const float* rs;
    __device__ __forceinline__ bool keep(const Unit&) const { return false; }
    __device__ __forceinline__ void operator()(Acc& acc, const Unit& u, int wr, int wc, int fr, int fq) const {
        const int row0 = u.pm * BM + wr * 64 + fr, col0 = u.pn * HALF + wc * 32 + 8 * fq;
#pragma unroll
        for (int ai = 0; ai < 2; ++ai)
#pragma unroll
            for (int m = 0; m < 4; ++m) { const int r = row0 + ai * HALF + m * 16; const float s = rs[r];
#pragma unroll
                for (int bj = 0; bj < 2; ++bj) { const f32x4 v0 = acc[ai][bj][m][0] * s, v1 = acc[ai][bj][m][1] * s;
                    u32x4 w; w.x = cvt_pk_bf16(v0[0], v0[1]); w.y = cvt_pk_bf16(v0[2], v0[3]); w.z = cvt_pk_bf16(v1[0], v1[1]); w.w = cvt_pk_bf16(v1[2], v1[3]);
                    *(u32x4*)((bj == 0 ? G : U) + (size_t)r * DFF + col0) = w; } }
    }
};
}

#define XB_TMO      128
#define XB_XCNT(j)  (256  + 64 * (j))
#define XB_XSUB(j)  (1280 + 64 * (j))
#define XB_XGEN(j)  (2304 + 64 * (j))
#define XB_TOP      3328
#define XB_TOPGEN   3392
#define XCD_BAR_WORDS 3456
#define XB_SPIN_CAP (1u << 18)
__device__ __forceinline__ unsigned xb_ld(unsigned* p)              { return __hip_atomic_load(p, __ATOMIC_RELAXED, __HIP_MEMORY_SCOPE_AGENT); }
__device__ __forceinline__ unsigned xb_add(unsigned* p, unsigned v) { return __hip_atomic_fetch_add(p, v, __ATOMIC_RELAXED, __HIP_MEMORY_SCOPE_AGENT); }
__device__ __forceinline__ unsigned xb_xcc_id() { return (unsigned)__builtin_amdgcn_s_getreg((3 << 11) | 20) & 0xFu; }
#define XB_SPIN(cond, bar) do { unsigned _sp = 0; while (cond) { __builtin_amdgcn_s_sleep(1); \
    if ((++_sp & 255u) == 0u) { if (xb_ld(&(bar)[XB_TMO])) break; if (_sp > XB_SPIN_CAP) { atomicAdd(&(bar)[XB_TMO], 1u); break; } } } } while (0)
struct XcdBarrier { unsigned* bar; unsigned x; volatile LAS unsigned* st; };
__device__ __forceinline__ XcdBarrier xcd_barrier_post(unsigned* bar, volatile LAS unsigned* st) {
    XcdBarrier b; b.bar = bar; b.x = xb_xcc_id(); b.st = st;
    if (threadIdx.x == 0) (void)xb_add(&bar[XB_XCNT(b.x)], 1u);
    return b;
}
__device__ __forceinline__ void xcd_barrier_complete(unsigned* bar, unsigned x, unsigned& nloc, unsigned& nx) {
    const unsigned G = gridDim.x * gridDim.y * gridDim.z;
    unsigned sum, cnt, mine, sp = 0u;
    for (;;) {
        sum = 0u; cnt = 0u; mine = 0u;
#pragma unroll
        for (unsigned j = 0; j < 16; ++j) { const unsigned c = xb_ld(&bar[XB_XCNT(j)]); sum += c; cnt += (c > 0u) ? 1u : 0u; mine = (j == x) ? c : mine; }
        if (sum == G) break;
        __builtin_amdgcn_s_sleep(1);
        if ((++sp & 255u) == 0u) { if (xb_ld(&bar[XB_TMO])) break; if (sp > XB_SPIN_CAP) { atomicAdd(&bar[XB_TMO], 1u); break; } }
    }
    nloc = mine > 0u ? mine : 1u; nx = cnt > 0u ? cnt : 1u;
}
__device__ __forceinline__ void xcd_barrier(const XcdBarrier& b) {
    asm volatile("s_waitcnt vmcnt(0)" ::: "memory");
    __syncthreads();
    if (threadIdx.x == 0) {
        unsigned* bar = b.bar;
        __builtin_amdgcn_s_waitcnt(0);
        unsigned nloc = b.st[0], nx = b.st[1];
        if (nloc == 0u) { xcd_barrier_complete(bar, b.x, nloc, nx); b.st[0] = nloc; b.st[1] = nx; }
        const unsigned old = xb_add(&bar[XB_XSUB(b.x)], 1u);
        const unsigned gen = old / nloc;
        if (old + 1u == (gen + 1u) * nloc) {
            __builtin_amdgcn_fence(__ATOMIC_RELEASE, "agent");
            asm volatile("s_waitcnt vmcnt(0)" ::: "memory");
            const unsigned og = xb_add(&bar[XB_TOP], 1u);
            const unsigned tg = og / nx;
            if (og + 1u == (tg + 1u) * nx) xb_add(&bar[XB_TOPGEN], 1u);
            else XB_SPIN(xb_ld(&bar[XB_TOPGEN]) == tg, bar);
            __builtin_amdgcn_fence(__ATOMIC_ACQUIRE, "agent");
            xb_add(&bar[XB_XGEN(b.x)], 1u);
            asm volatile("s_waitcnt vmcnt(0)" ::: "memory");
        } else {
            XB_SPIN(xb_ld(&bar[XB_XGEN(b.x)]) == gen, bar);
            __builtin_amdgcn_fence(__ATOMIC_ACQUIRE, "agent");
            asm volatile("s_waitcnt vmcnt(0)" ::: "memory");
        }
    }
    __syncthreads();
}

struct Frame {
    LAS unsigned char* lds;
    int tid, lane, wave, vcu, G;
    const float* in[19]; float* out; unsigned char* ws;
};
__device__ __forceinline__ float* hrow_ptr(const Frame& F, int r) { return r < MX ? F.out + (size_t)r * D : (float*)(F.ws + WS_HM) + (size_t)(r - MX) * D; }
__device__ __forceinline__ int prev_row(int r, int j) {
    if (r < MX) { const int t = r & (SEQ - 1); if (t >= j) return r - j; const int m = NMETA + t - j; return m >= 0 ? META0 + m : -1; }
    const int m = r - META0 - j; return m >= 0 ? META0 + m : -1;
}

__device__ __forceinline__ void tr_store(LAS float* scr, bf16* dst, int ldd, int n0d, int kd0, int lane) {
    LDS_WAIT(); asm volatile("" ::: "memory");
    const int c = lane & 7;
#pragma unroll
    for (int j = 0; j < 4; ++j) { const int n = (lane >> 3) + 8 * j; const LAS float* s = scr + (8 * c) * 33 + n;
        u32x4 o; o.x = pk2(s[0 * 33], s[1 * 33]); o.y = pk2(s[2 * 33], s[3 * 33]); o.z = pk2(s[4 * 33], s[5 * 33]); o.w = pk2(s[6 * 33], s[7 * 33]);
        *(u32x4*)(dst + (size_t)(n0d + n) * ldd + kd0 + 8 * c) = o; }
    LDS_WAIT(); asm volatile("" ::: "memory");
}
__device__ __forceinline__ void tr_item(const float* src, int lds_, int n0s, int k0, const float* gain, bf16* dst, int ldd, int n0d, int kd0, LAS float* scr, int lane) {
#pragma unroll 8
    for (int i = 0; i < 32; ++i) { const int kk = 2 * i + (lane >> 5); float v = src[(size_t)(k0 + kk) * lds_ + n0s + (lane & 31)]; if (gain) v *= gain[k0 + kk]; scr[kk * 33 + (lane & 31)] = v; }
    tr_store(scr, dst, ldd, n0d, kd0, lane);
}
__device__ __forceinline__ void wp_item(const float* pp, const float* ps, const float* wbp, int k0, int n0, bf16* dst, int ldd, int kd0, LAS float* scr, int lane) {
    const int g = k0 >> 7, c0 = (k0 & 127) + 32 * (lane >> 5), n = n0 + (lane & 31);
    float acc[32];
#pragma unroll
    for (int i = 0; i < 32; ++i) acc[i] = 0.f;
    const float* ppg = pp + (size_t)g * 128 * 128 + (size_t)c0 * 128;
    for (int d = 0; d < 128; ++d) { const float x = ps[g * 128 + d] * wbp[(size_t)(g * 128 + d) * D + n];
#pragma unroll
        for (int i = 0; i < 32; ++i) acc[i] += ppg[i * 128 + d] * x; }
#pragma unroll
    for (int i = 0; i < 32; ++i) scr[(32 * (lane >> 5) + i) * 33 + (lane & 31)] = acc[i];
    tr_store(scr, dst, ldd, n0, kd0, lane);
}
__device__ __forceinline__ void phase_prologue(Frame& F) {
    LAS float* scr = (LAS float*)(F.lds + F.wave * 16384);
    const int gw = F.vcu * 8 + F.wave, NGW = F.G * 8;
    constexpr int I_INA = 16 * (NA / 32), I_G = 16 * (NG / 32), I_ZH = 8 * 32, I_ZP = 8 * 32, I_OUT = 16 * 32, I_GU = 16 * (NGU / 32), I_DN = (DFF / 64) * 32;
    constexpr int I_LAYER = I_INA + I_G + I_ZH + I_ZP + I_OUT + I_GU + I_DN;
    for (int it = gw; it < DEPTH * I_LAYER; it += NGW) {
        const int l = it / I_LAYER; int r = it % I_LAYER;
        bf16* W = (bf16*)(F.ws + WS_W + (size_t)l * WL_BYTES);
        if (r < I_INA) { const int nblk = NA / 32, kb = r / nblk, nb = r % nblk;
            tr_item(F.in[4] + (size_t)l * D * INC, INC, 32 * nb, 64 * kb, F.in[2] + l * D, (bf16*)((char*)W + WL_INA), D, 32 * nb, 64 * kb, scr, F.lane); continue; } r -= I_INA;
        if (r < I_G) { const int nblk = NG / 32, kb = r / nblk, nb = r % nblk, n0d = 32 * nb, p = n0d >> 8, j = n0d & 255;
            const int n0s = (j < 128) ? (2560 + 128 * p + j) : (3584 + 128 * p + (j - 128));
            tr_item(F.in[4] + (size_t)l * D * INC, INC, n0s, 64 * kb, F.in[2] + l * D, (bf16*)((char*)W + WL_G), D, n0d, 64 * kb, scr, F.lane); continue; } r -= I_G;
        if (r < I_ZH) { const int kb = r / 32, nb = r % 32;
            tr_item(F.in[7] + (size_t)l * 512 * D, D, 32 * nb, 64 * kb, F.in[6] + l * 512, (bf16*)((char*)W + WL_Z), D, 32 * nb, 64 * kb, scr, F.lane); continue; } r -= I_ZH;
        if (r < I_ZP) { const int kb = r / 32, nb = r % 32;
            wp_item(F.in[8] + (size_t)l * 4 * 128 * 128, F.in[9] + l * 512, F.in[10] + (size_t)l * 512 * D, 64 * kb, 32 * nb, (bf16*)((char*)W + WL_Z), D, 512 + 64 * kb, scr, F.lane); continue; } r -= I_ZP;
        if (r < I_OUT) { const int kb = r / 32, nb = r % 32;
            tr_item(F.in[11] + (size_t)l * D * D, D, 32 * nb, 64 * kb, nullptr, (bf16*)((char*)W + WL_OUT), D, 32 * nb, 64 * kb, scr, F.lane); continue; } r -= I_OUT;
        if (r < I_GU) { const int nblk = NGU / 32, kb = r / nblk, nb = r % nblk, n0d = 32 * nb, p = n0d >> 8, j = n0d & 255;
            const float* src = (j < 128 ? F.in[14] : F.in[15]) + (size_t)l * D * DFF;
            tr_item(src, DFF, 128 * p + (j & 127), 64 * kb, F.in[12] + l * D, (bf16*)((char*)W + WL_GU), D, n0d, 64 * kb, scr, F.lane); continue; } r -= I_GU;
        { const int kb = r / 32, nb = r % 32;
            tr_item(F.in[18] + (size_t)l * DFF * D, D, 32 * nb, 64 * kb, nullptr, (bf16*)((char*)W + WL_DN), DFF, 32 * nb, 64 * kb, scr, F.lane); }
    }
    bf16* HB = (bf16*)(F.ws + WS_HB); float* RS = (float*)(F.ws + WS_RS);
    for (int r = gw; r < MROWS; r += NGW) {
        f32x4 v[4];
        if (r < MX) {
#pragma unroll
            for (int j = 0; j < 4; ++j) v[j] = *((const f32x4*)(F.in[0] + (size_t)r * D) + F.lane + 64 * j);
        } else if (r < MX + NMETA) {
#pragma unroll
            for (int j = 0; j < 4; ++j) v[j] = *((const f32x4*)(F.in[1] + (size_t)(r - MX) * D) + F.lane + 64 * j);
        } else {
#pragma unroll
            for (int j = 0; j < 4; ++j) v[j] = (f32x4){0.f, 0.f, 0.f, 0.f};
        }
        float ss = 0.f;
#pragma unroll
        for (int j = 0; j < 4; ++j) ss += (v[j].x * v[j].x + v[j].y * v[j].y) + (v[j].z * v[j].z + v[j].w * v[j].w);
        ss = wave_sum(ss);
        float* hp = hrow_ptr(F, r);
#pragma unroll
        for (int j = 0; j < 4; ++j) { *((f32x4*)hp + F.lane + 64 * j) = v[j];
            u32x2 w; w.x = pk2(v[j].x, v[j].y); w.y = pk2(v[j].z, v[j].w); *((u32x2*)(HB + (size_t)r * D) + F.lane + 64 * j) = w; }
        if (F.lane == 0) RS[r] = 1.0f / sqrtf(ss * (1.0f / D) + EPS);
    }
    if (blockIdx.x == 0) { float* LB = (float*)(F.ws + WS_LB);
        for (int k = F.tid; k < 512; k += 512) { const float x0 = F.in[5][k], x1 = F.in[5][512 + k]; const float mx = fmaxf(x0, x1), e0 = __expf(x0 - mx), e1 = __expf(x1 - mx);
            const float g0 = e0 / (e0 + e1), g1 = e1 / (e0 + e1); float lb1 = (g0 + g1) - g0; lb1 = fminf(fmaxf(lb1, 0.f), 1.f); LB[k] = 0.f; LB[512 + k] = lb1; } }
}

namespace hg {
constexpr int SQ = 136, S72 = 72;
constexpr int L_QS = 0, L_QD = L_QS + 64 * SQ * 2, L_KS = L_QD + 64 * SQ * 2, L_KDT = L_KS + 64 * SQ * 2, L_VT = L_KDT + 128 * S72 * 2, L_P = L_VT + 128 * S72 * 2,
              L_ST = L_P + 64 * S72 * 2, L_CP = L_ST + 128 * SQ * 2, L_DL = L_CP + 8 * 128 * 4, L_RSS = L_DL + 128 * 4, L_END = L_RSS + 2 * 64 * 4;
static_assert(L_END <= MISC_OFF, "hgrn LDS");
__device__ __forceinline__ f32x4 mfma16(bf16x8 a, bf16x8 b, f32x4 c) { return __builtin_amdgcn_mfma_f32_16x16x32_bf16(a, b, c, 0, 0, 0); }

template <bool OUT>
__device__ __forceinline__ void chunk(LAS unsigned char* lds, const bf16* PA, bf16* AP, int r0, int h, int nvalid, const float* lbh, f32x4 (&Sacc)[8], float& dsum0, float& dsum1, int tid) {
    const int w = __builtin_amdgcn_readfirstlane(tid >> 6), lane = tid & 63, fr = lane & 15, fq = lane >> 4;
    LAS bf16* QS = (LAS bf16*)(lds + L_QS); LAS bf16* QD = (LAS bf16*)(lds + L_QD); LAS bf16* KS = (LAS bf16*)(lds + L_KS);
    LAS bf16* KDT = (LAS bf16*)(lds + L_KDT); LAS bf16* VT = (LAS bf16*)(lds + L_VT); LAS bf16* P = (LAS bf16*)(lds + L_P); LAS bf16* ST = (LAS bf16*)(lds + L_ST);
    LAS float* CP = (LAS float*)(lds + L_CP); LAS float* DL = (LAS float*)(lds + L_DL); LAS float* RSS = (LAS float*)(lds + L_RSS);
    const int k0 = 2 * lane;
    const float lb0 = lbh[k0], lb1 = lbh[k0 + 1];
    float c0[8], c1[8], kk0[8], kk1[8], q0[8], q1[8];
    float run0 = 0.f, run1 = 0.f;
#pragma unroll
    for (int j = 0; j < 8; ++j) { const int t = 8 * w + j; const bool valid = t < nvalid;
        unsigned fw = 0u, qw = 0u;
        if (valid) { const bf16* rowp = PA + (size_t)(r0 + t) * NA + h * 128 + k0; qw = *(const unsigned*)rowp; fw = *(const unsigned*)(rowp + 512); }
        const float f0 = bflo(fw), f1 = bfhi(fw);
        { const float e = __expf(-fabsf(f0)), sp = 1.0f / (1.0f + e), sn = e * sp; const float sg = f0 >= 0.f ? sp : sn, sgn = f0 >= 0.f ? sn : sp;
          const float f = lb0 + (1.0f - lb0) * sg; float lf = __logf(fmaxf(f, 1e-30f)); float kk = (1.0f - lb0) * sgn; if (!valid) { lf = 0.f; kk = 0.f; }
          run0 += lf; c0[j] = run0; kk0[j] = kk; q0[j] = bflo(qw); }
        { const float e = __expf(-fabsf(f1)), sp = 1.0f / (1.0f + e), sn = e * sp; const float sg = f1 >= 0.f ? sp : sn, sgn = f1 >= 0.f ? sn : sp;
          const float f = lb1 + (1.0f - lb1) * sg; float lf = __logf(fmaxf(f, 1e-30f)); float kk = (1.0f - lb1) * sgn; if (!valid) { lf = 0.f; kk = 0.f; }
          run1 += lf; c1[j] = run1; kk1[j] = kk; q1[j] = bfhi(qw); }
    }
    CP[w * 128 + k0] = run0; CP[w * 128 + k0 + 1] = run1;
    u32x4 va = (u32x4){0u, 0u, 0u, 0u}, vb = va;
    if (lane < nvalid) { const bf16* vp = PA + (size_t)(r0 + lane) * NA + 1024 + h * 128 + 16 * w; va = *(const u32x4*)vp; vb = *(const u32x4*)(vp + 8); }
    __syncthreads();
    float pre0 = 0.f, pre1 = 0.f, tot0 = 0.f, tot1 = 0.f, mid0 = 0.f, mid1 = 0.f;
#pragma unroll
    for (int ww = 0; ww < 8; ++ww) { const float x0 = CP[ww * 128 + k0], x1 = CP[ww * 128 + k0 + 1];
        if (ww < w) { pre0 += x0; pre1 += x1; } if (ww < 4) { mid0 += x0; mid1 += x1; } tot0 += x0; tot1 += x1; }
    {
        unsigned kd0[4], kd1[4];
#pragma unroll
        for (int j = 0; j < 8; ++j) { const int t = 8 * w + j;
            const float b0 = pre0 + c0[j], b1 = pre1 + c1[j];
            const float qd0 = q0[j] * __expf(b0), qd1 = q1[j] * __expf(b1);
            const float qs0 = q0[j] * __expf(fminf(b0 - mid0, 80.f)), qs1 = q1[j] * __expf(fminf(b1 - mid1, 80.f));
            const float ks0 = kk0[j] * __expf(fminf(mid0 - b0, 80.f)), ks1 = kk1[j] * __expf(fminf(mid1 - b1, 80.f));
            const float kdv0 = kk0[j] * __expf(tot0 - b0), kdv1 = kk1[j] * __expf(tot1 - b1);
            *(LAS unsigned*)(QD + t * SQ + k0) = pk2(qd0, qd1);
            *(LAS unsigned*)(QS + t * SQ + k0) = pk2(qs0, qs1);
            *(LAS unsigned*)(KS + t * SQ + k0) = pk2(ks0, ks1);
            if (j & 1) { kd0[j >> 1] |= f2bf(kdv0) << 16; kd1[j >> 1] |= f2bf(kdv1) << 16; } else { kd0[j >> 1] = f2bf(kdv0); kd1[j >> 1] = f2bf(kdv1); }
        }
        *(LAS u32x4*)(KDT + k0 * S72 + 8 * w) = (u32x4){kd0[0], kd0[1], kd0[2], kd0[3]};
        *(LAS u32x4*)(KDT + (k0 + 1) * S72 + 8 * w) = (u32x4){kd1[0], kd1[1], kd1[2], kd1[3]};
    }
    if (w == 0) { DL[k0] = __expf(tot0); DL[k0 + 1] = __expf(tot1); dsum0 += tot0; dsum1 += tot1; }
    {
        const unsigned vv[8] = {va.x, va.y, va.z, va.w, vb.x, vb.y, vb.z, vb.w};
#pragma unroll
        for (int j = 0; j < 8; ++j) { VT[(16 * w + 2 * j) * S72 + lane] = (bf16)(vv[j] & 0xffffu); VT[(16 * w + 2 * j + 1) * S72 + lane] = (bf16)(vv[j] >> 16); }
    }
    if (OUT) {
#pragma unroll
        for (int cb = 0; cb < 8; ++cb) { u32x2 wv; wv.x = pk2(Sacc[cb][0], Sacc[cb][1]); wv.y = pk2(Sacc[cb][2], Sacc[cb][3]);
            *(LAS u32x2*)(ST + (cb * 16 + fr) * SQ + 16 * w + 4 * fq) = wv; }
    }
    __syncthreads();
    if (OUT) {
        const int tb = w >> 1;
#pragma unroll
        for (int blk = 0; blk < 2; ++blk) { const int sb = 2 * (w & 1) + blk; f32x4 acc = (f32x4){0.f, 0.f, 0.f, 0.f};
            if (sb <= tb) {
#pragma unroll
                for (int ks = 0; ks < 4; ++ks) { const bf16x8 a = *(const LAS bf16x8*)(KS + (sb * 16 + fr) * SQ + ks * 32 + 8 * fq); const bf16x8 b = *(const LAS bf16x8*)(QS + (tb * 16 + fr) * SQ + ks * 32 + 8 * fq);
                    acc = mfma16(a, b, acc); } }
            const int t = tb * 16 + fr, s0 = sb * 16 + 4 * fq;
            u32x2 wv; wv.x = pk2(s0 + 0 <= t ? acc[0] : 0.f, s0 + 1 <= t ? acc[1] : 0.f); wv.y = pk2(s0 + 2 <= t ? acc[2] : 0.f, s0 + 3 <= t ? acc[3] : 0.f);
            *(LAS u32x2*)(P + t * S72 + s0) = wv; }
    }
    f32x4 oacc[4];
    {
        const f32x4 dl = *(const LAS f32x4*)(DL + 16 * w + 4 * fq);
        bf16x8 a[2];
#pragma unroll
        for (int ks = 0; ks < 2; ++ks) a[ks] = *(const LAS bf16x8*)(KDT + (16 * w + fr) * S72 + ks * 32 + 8 * fq);
#pragma unroll
        for (int cb = 0; cb < 8; ++cb) { f32x4 s = Sacc[cb] * dl;
#pragma unroll
            for (int ks = 0; ks < 2; ++ks) { const bf16x8 b = *(const LAS bf16x8*)(VT + (cb * 16 + fr) * S72 + ks * 32 + 8 * fq); s = mfma16(a[ks], b, s); }
            Sacc[cb] = s; }
    }
    if (OUT) {
        __syncthreads();
        const int tb = w & 3, ch = w >> 2;
#pragma unroll
        for (int i = 0; i < 4; ++i) oacc[i] = (f32x4){0.f, 0.f, 0.f, 0.f};
#pragma unroll
        for (int ks = 0; ks < 2; ++ks) { const bf16x8 b = *(const LAS bf16x8*)(P + (tb * 16 + fr) * S72 + ks * 32 + 8 * fq);
#pragma unroll
            for (int i = 0; i < 4; ++i) { const bf16x8 a = *(const LAS bf16x8*)(VT + ((ch * 4 + i) * 16 + fr) * S72 + ks * 32 + 8 * fq); oacc[i] = mfma16(a, b, oacc[i]); } }
#pragma unroll
        for (int ks = 0; ks < 4; ++ks) { const bf16x8 b = *(const LAS bf16x8*)(QD + (tb * 16 + fr) * SQ + ks * 32 + 8 * fq);
#pragma unroll
            for (int i = 0; i < 4; ++i) { const bf16x8 a = *(const LAS bf16x8*)(ST + ((ch * 4 + i) * 16 + fr) * SQ + ks * 32 + 8 * fq); oacc[i] = mfma16(a, b, oacc[i]); } }
        float ss = 0.f;
#pragma unroll
        for (int i = 0; i < 4; ++i) ss += (oacc[i][0] * oacc[i][0] + oacc[i][1] * oacc[i][1]) + (oacc[i][2] * oacc[i][2] + oacc[i][3] * oacc[i][3]);
        ss += __shfl_xor(ss, 16); ss += __shfl_xor(ss, 32);
        if (lane < 16) RSS[ch * 64 + tb * 16 + lane] = ss;
        __syncthreads();
        const int t = tb * 16 + fr;
        const float rn = 1.0f / sqrtf((RSS[t] + RSS[64 + t]) * (1.0f / 128.0f) + EPS);
        if (t < nvalid) {
#pragma unroll
            for (int i = 0; i < 4; ++i) { const int c = (ch * 4 + i) * 16 + 4 * fq;
                const u32x2 gw = *(const u32x2*)(PA + (size_t)(r0 + t) * NA + 1536 + h * 128 + c);
                u32x2 wv; wv.x = pk2(oacc[i][0] * rn * bflo(gw.x), oacc[i][1] * rn * bfhi(gw.x)); wv.y = pk2(oacc[i][2] * rn * bflo(gw.y), oacc[i][3] * rn * bfhi(gw.y));
                *(u32x2*)(AP + (size_t)(r0 + t) * D + h * 128 + c) = wv; }
        }
    }
}
}

__device__ __forceinline__ void phase_pool(Frame& F, const bf16* PA, bf16* AP) {
    for (int it = F.vcu; it < 513 * 4; it += F.G) {
        const int rb = it >> 2, g = it & 3, wn = 2 << g, c = g * 128 + 2 * F.lane;
#pragma unroll 1
        for (int j = 0; j < 8; ++j) { const int r = rb * 64 + 8 * F.wave + j;
            if (r >= META0 + NMETA) continue;
            float s0 = 0.f, s1 = 0.f, v0 = 0.f, v1 = 0.f; int cnt = 0;
            for (int jj = 0; jj < wn; ++jj) { const int pr = prev_row(r, jj); if (pr < 0) break;
                const unsigned wv = *(const unsigned*)(PA + (size_t)pr * NA + 2048 + c); const float a0 = bflo(wv), a1 = bfhi(wv);
                if (jj == 0) { v0 = a0; v1 = a1; } s0 += a0; s1 += a1; ++cnt; }
            const float ic = 1.0f / (float)cnt;
            *(unsigned*)(AP + (size_t)r * D + 512 + c) = pk2(s0 * ic - v0, s1 * ic - v1); }
    }
}

__device__ __forceinline__ void hgrn_store_state(float* dst, const f32x4 (&Sacc)[8], int tid) {
#pragma unroll
    for (int cb = 0; cb < 8; ++cb)
#pragma unroll
        for (int i = 0; i < 4; ++i) dst[(cb * 4 + i) * 512 + tid] = Sacc[cb][i];
}
__device__ __forceinline__ void phase_hgrn_a(Frame& F, int l, const bf16* PA, bf16* AP) {
    unsigned char* big = F.ws + WS_BIG;
    const float* LB = (const float*)(F.ws + WS_LB) + l * 512;
    f32x4 Sacc[8];
    if (F.vcu < 4) {
        const int h = F.vcu; float d0 = 0.f, d1 = 0.f;
#pragma unroll
        for (int cb = 0; cb < 8; ++cb) Sacc[cb] = (f32x4){0.f, 0.f, 0.f, 0.f};
        hg::chunk<true>(F.lds, PA, AP, META0, h, NMETA, LB + h * 128, Sacc, d0, d1, F.tid);
        hgrn_store_state((float*)(big + B_SM) + (size_t)h * 16384, Sacc, F.tid);
        __syncthreads();
    }
    for (int u = F.vcu; u < 256; u += F.G) {
        const int b = u >> 6, h = (u >> 4) & 3, j = u & 15; float d0 = 0.f, d1 = 0.f;
#pragma unroll
        for (int cb = 0; cb < 8; ++cb) Sacc[cb] = (f32x4){0.f, 0.f, 0.f, 0.f};
        for (int i = 0; i < 8; ++i) hg::chunk<false>(F.lds, PA, AP, b * SEQ + 64 * (8 * j + i), h, 64, LB + h * 128, Sacc, d0, d1, F.tid);
        hgrn_store_state((float*)(big + B_KV) + (size_t)u * 16384, Sacc, F.tid);
        if (F.wave == 0) { float* DD = (float*)(big + B_DD) + u * 128; DD[2 * F.lane] = __expf(d0); DD[2 * F.lane + 1] = __expf(d1); }
        __syncthreads();
    }
}
__device__ __forceinline__ void phase_hgrn_b(Frame& F) {
    unsigned char* big = F.ws + WS_BIG;
    const float* KV = (const float*)(big + B_KV); float* SS = (float*)(big + B_SS); const float* SM = (const float*)(big + B_SM); const float* DD = (const float*)(big + B_DD);
    for (int g = F.vcu * 512 + F.tid; g < 16 * 16384; g += F.G * 512) {
        const int bh = g >> 14, e = g & 16383, h = bh & 3, tidx = e & 511, reg = e >> 9;
        const int k = 16 * (tidx >> 6) + 4 * ((tidx & 63) >> 4) + (reg & 3);
        float s = SM[(size_t)h * 16384 + e];
        for (int j = 0; j < 16; ++j) { const int u = bh * 16 + j; SS[(size_t)u * 16384 + e] = s; s = DD[u * 128 + k] * s + KV[(size_t)u * 16384 + e]; }
    }
}
__device__ __forceinline__ void phase_hgrn_c(Frame& F, int l, const bf16* PA, bf16* AP) {
    unsigned char* big = F.ws + WS_BIG;
    const float* LB = (const float*)(F.ws + WS_LB) + l * 512;
    f32x4 Sacc[8];
    for (int u = F.vcu; u < 256; u += F.G) {
        const int b = u >> 6, h = (u >> 4) & 3, j = u & 15; float d0 = 0.f, d1 = 0.f;
        const float* src = (const float*)(big + B_SS) + (size_t)u * 16384;
#pragma unroll
        for (int cb = 0; cb < 8; ++cb)
#pragma unroll
            for (int i = 0; i < 4; ++i) Sacc[cb][i] = src[(cb * 4 + i) * 512 + F.tid];
        for (int i = 0; i < 8; ++i) hg::chunk<true>(F.lds, PA, AP, b * SEQ + 64 * (8 * j + i), h, 64, LB + h * 128, Sacc, d0, d1, F.tid);
        __syncthreads();
    }
}

__device__ __forceinline__ void phase_ln_res(Frame& F, const float* Y, const float* gain) {
    const int gw = F.vcu * 8 + F.wave, NGW = F.G * 8;
    bf16* HB = (bf16*)(F.ws + WS_HB); float* RS = (float*)(F.ws + WS_RS);
    f32x4 gv[4];
#pragma unroll
    for (int j = 0; j < 4; ++j) gv[j] = *((const f32x4*)gain + F.lane + 64 * j);
    for (int r = gw; r < MROWS; r += NGW) {
        float* hp = hrow_ptr(F, r);
        f32x4 y[4], hv[4]; float ss = 0.f;
#pragma unroll
        for (int j = 0; j < 4; ++j) { y[j] = *((const f32x4*)(Y + (size_t)r * D) + F.lane + 64 * j); hv[j] = *((const f32x4*)hp + F.lane + 64 * j);
            ss += (y[j].x * y[j].x + y[j].y * y[j].y) + (y[j].z * y[j].z + y[j].w * y[j].w); }
        const float rn = 1.0f / sqrtf(wave_sum(ss) * (1.0f / D) + EPS);
        float s2 = 0.f;
#pragma unroll
        for (int j = 0; j < 4; ++j) { hv[j] = hv[j] + y[j] * rn * gv[j]; s2 += (hv[j].x * hv[j].x + hv[j].y * hv[j].y) + (hv[j].z * hv[j].z + hv[j].w * hv[j].w); }
        s2 = wave_sum(s2);
#pragma unroll
        for (int j = 0; j < 4; ++j) { *((f32x4*)hp + F.lane + 64 * j) = hv[j];
            u32x2 w; w.x = pk2(hv[j].x, hv[j].y); w.y = pk2(hv[j].z, hv[j].w); *((u32x2*)(HB + (size_t)r * D) + F.lane + 64 * j) = w; }
        if (F.lane == 0) RS[r] = 1.0f / sqrtf(s2 * (1.0f / D) + EPS);
    }
}

__device__ __forceinline__ float gelu_tanh(float x) {
    const float y = 0.7978845608028654f * (x + 0.044715f * x * x * x);
    const float e = __expf(-2.0f * fabsf(y)); const float th = (1.0f - e) / (1.0f + e);
    return 0.5f * x * (1.0f + (y >= 0.f ? th : -th));
}
__device__ __forceinline__ void phase_conv(Frame& F, int l, const bf16* G, bf16* U) {
    const float* cw = F.in[16] + (size_t)l * 3 * DFF; const float* cb = F.in[17] + (size_t)l * DFF;
    constexpr int CG = DFF / 8;
    for (int idx = F.vcu * 512 + F.tid; idx < MROWS * CG; idx += F.G * 512) {
        const int r = idx / CG, c = (idx % CG) * 8;
        const int r1 = (r < META0 + NMETA) ? prev_row(r, 1) : -1, r2 = (r < META0 + NMETA) ? prev_row(r, 2) : -1;
        const u32x4 z = (u32x4){0u, 0u, 0u, 0u};
        const u32x4 g2 = *(const u32x4*)(G + (size_t)r * DFF + c);
        const u32x4 g1 = r1 >= 0 ? *(const u32x4*)(G + (size_t)r1 * DFF + c) : z;
        const u32x4 g0 = r2 >= 0 ? *(const u32x4*)(G + (size_t)r2 * DFF + c) : z;
        const u32x4 uu = *(const u32x4*)(U + (size_t)r * DFF + c);
        const unsigned a0[4] = {g0.x, g0.y, g0.z, g0.w}, a1[4] = {g1.x, g1.y, g1.z, g1.w}, a2[4] = {g2.x, g2.y, g2.z, g2.w}, au[4] = {uu.x, uu.y, uu.z, uu.w};
        unsigned o[4];
#pragma unroll
        for (int e = 0; e < 4; ++e) { const int cc = c + 2 * e;
            const float x0 = cb[cc] + cw[cc] * bflo(a0[e]) + cw[DFF + cc] * bflo(a1[e]) + cw[2 * DFF + cc] * bflo(a2[e]);
            const float x1 = cb[cc + 1] + cw[cc + 1] * bfhi(a0[e]) + cw[DFF + cc + 1] * bfhi(a1[e]) + cw[2 * DFF + cc + 1] * bfhi(a2[e]);
            o[e] = pk2(gelu_tanh(x0) * bflo(au[e]), gelu_tanh(x1) * bfhi(au[e])); }
        *(u32x4*)(U + (size_t)r * DFF + c) = (u32x4){o[0], o[1], o[2], o[3]};
    }
}

struct Args { const float* in[19]; float* out; unsigned char* ws; int ph_lo, ph_hi, li, pad; };
constexpr int PH_PER_LAYER = 12, N_PHASES = 1 + DEPTH * PH_PER_LAYER;

__global__ void __launch_bounds__(512, 2) trunk_fwd(Args args) {
    extern __shared__ __attribute__((aligned(16))) unsigned char lds_raw[];
    Frame F;
    F.lds = (LAS unsigned char*)lds_raw;
    F.tid = threadIdx.x; F.lane = F.tid & 63; F.wave = __builtin_amdgcn_readfirstlane(F.tid >> 6);
    F.G = gridDim.x; { const int bx = blockIdx.x; F.vcu = (F.G % 8 == 0) ? (bx % 8) * (F.G / 8) + bx / 8 : bx; }
#pragma unroll
    for (int i = 0; i < 19; ++i) F.in[i] = args.in[i];
    F.out = args.out; F.ws = args.ws;
    volatile LAS unsigned* MISC = (volatile LAS unsigned*)(F.lds + MISC_OFF);
    if (F.tid < 64) MISC[F.tid] = 0u;
    __syncthreads();
#if MK_ONE_LAUNCH
    XcdBarrier bar = xcd_barrier_post((unsigned*)(F.ws + WS_CTL) + CW_BAR, MISC + 8);
#define GRID_BAR() xcd_barrier(bar)
#else
#define GRID_BAR() do {} while (0)
#endif
    const int lo = args.ph_lo, hi = args.ph_hi;
    unsigned char* big = F.ws + WS_BIG;
    bf16* HB = (bf16*)(F.ws + WS_HB); const float* RS = (const float*)(F.ws + WS_RS);
    int ph = 0;
#ifndef MK_ONLY
#define MK_ONLY -1
#endif
    constexpr int cbase = __COUNTER__ + 1;
#define PHASE(...) do { constexpr int pid_ = __COUNTER__ - cbase; if constexpr (MK_ONLY < 0 || MK_ONLY == pid_) { if (lo <= ph && ph < hi) { { int t_ = threadIdx.x; asm volatile("" : "+v"(t_)); F.tid = t_; F.lane = t_ & 63; F.wave = __builtin_amdgcn_readfirstlane(t_ >> 6); } __VA_ARGS__; if (ph + 1 < hi) GRID_BAR(); } } ++ph; } while (0)

    PHASE(phase_prologue(F));
    for (int l = 0; l < DEPTH; ++l) {
        const bf16* W = (const bf16*)(F.ws + WS_W + (size_t)l * WL_BYTES);
        bf16* PA = (bf16*)(big + B_PA); bf16* AP = (bf16*)(big + B_AP); bf16* Z = (bf16*)(big + B_Z); bf16* GT = (bf16*)(big + B_PA); float* Y1 = (float*)(big + B_PA);
        bf16* Gb = (bf16*)(big + B_G); bf16* Ub = (bf16*)(big + B_U); float* Y2 = (float*)(big + B_G);
        PHASE({ pg8::Gemm g{HB, (const bf16*)((const char*)W + WL_INA), D, D, D, 0}; pg8::StaticOrder S; S.init(MROWS, NA, F.G, (int)blockIdx.x);
                pg8::EpiProjA E{PA, RS}; pg8::gemm_phase<pg8::EpiProjA, pg8::StaticOrder, true>(F.lds, g, S, E, F.tid); });
        PHASE({ phase_pool(F, PA, AP); phase_hgrn_a(F, l, PA, AP); });
        PHASE(phase_hgrn_b(F));
        PHASE(phase_hgrn_c(F, l, PA, AP));
        PHASE({ pg8::Gemm g{HB, (const bf16*)((const char*)W + WL_G), D, D, D, 0}; pg8::StaticOrder S; S.init(MROWS, NG, F.G, (int)blockIdx.x);
                pg8::EpiGates E{GT, RS}; pg8::gemm_phase<pg8::EpiGates, pg8::StaticOrder, true>(F.lds, g, S, E, F.tid); });
        PHASE({ pg8::Gemm g{AP, (const bf16*)((const char*)W + WL_Z), D, D, 512, 512}; pg8::PairOrder S; S.init(MROWS, D, F.G, (int)blockIdx.x);
                pg8::EpiZ E{GT, Z}; pg8::gemm_phase<pg8::EpiZ, pg8::PairOrder, true>(F.lds, g, S, E, F.tid); });
        PHASE({ pg8::Gemm g{Z, (const bf16*)((const char*)W + WL_OUT), D, D, D, 0}; pg8::StaticOrder S; S.init(MROWS, D, F.G, (int)blockIdx.x);
                pg8::EpiF32 E{Y1, D}; pg8::gemm_phase<pg8::EpiF32, pg8::StaticOrder, true>(F.lds, g, S, E, F.tid); });
        PHASE(phase_ln_res(F, Y1, F.in[3] + l * D));
        PHASE({ pg8::Gemm g{HB, (const bf16*)((const char*)W + WL_GU), D, D, D, 0}; pg8::StaticOrder S; S.init(MROWS, NGU, F.G, (int)blockIdx.x);
                pg8::EpiGU E{Gb, Ub, RS}; pg8::gemm_phase<pg8::EpiGU, pg8::StaticOrder, true>(F.lds, g, S, E, F.tid); });
        PHASE(phase_conv(F, l, Gb, Ub));
        PHASE({ pg8::Gemm g{Ub, (const bf16*)((const char*)W + WL_DN), DFF, DFF, DFF, 0}; pg8::StaticOrder S; S.init(MROWS, D, F.G, (int)blockIdx.x);
                pg8::EpiF32 E{Y2, D}; pg8::gemm_phase<pg8::EpiF32, pg8::StaticOrder, true>(F.lds, g, S, E, F.tid); });
        PHASE(phase_ln_res(F, Y2, F.in[13] + l * D));
    }
}

extern "C" void kernel_launch(void* const* d_in, const int* in_sizes, int n_in, void* d_out, int out_size, void* d_ws, size_t ws_size, hipStream_t stream) {
    static int grid = 0;
    if (grid == 0) {
        if (n_in != 19 || out_size != MX * D || ws_size < WS_END) { fprintf(stderr, "kernel_launch: unexpected problem (n_in %d out %d ws %zu, need %zu)\n", n_in, out_size, ws_size, (size_t)WS_END); grid = -1; return; }
        int dev = 0, cus = 0;
        if (hipGetDevice(&dev) != hipSuccess || hipDeviceGetAttribute(&cus, hipDeviceAttributeMultiprocessorCount, dev) != hipSuccess) { grid = -1; return; }
        if (hipFuncSetAttribute((const void*)trunk_fwd, hipFuncAttributeMaxDynamicSharedMemorySize, LDS_BYTES) != hipSuccess) { fprintf(stderr, "kernel_launch: hipFuncSetAttribute failed\n"); grid = -1; return; }
        (void)hipGetLastError();
        grid = cus;
    }
    if (grid < 0) return;
    (void)hipMemsetAsync((char*)d_ws + WS_CTL, 0, CTL_BYTES, stream);
    Args a{};
    for (int i = 0; i < 19; ++i) a.in[i] = (const float*)d_in[i];
    a.out = (float*)d_out; a.ws = (unsigned char*)d_ws;
#if MK_ONE_LAUNCH
    a.ph_lo = 0; a.ph_hi = N_PHASES; a.li = 0;
    hipLaunchKernelGGL(trunk_fwd, dim3(grid), dim3(512), LDS_BYTES, stream, a);
#else
    for (int p = 0; p < N_PHASES; ++p) { a.ph_lo = p; a.ph_hi = p + 1; a.li = p; hipLaunchKernelGGL(trunk_fwd, dim3(grid), dim3(512), LDS_BYTES, stream, a); }
#endif
}
```

```cpp
#include <hip/hip_runtime.h>
#include <cstdio>
#include <cstdint>

#ifndef MK_ONE_LAUNCH
#define MK_ONE_LAUNCH 1
#endif

#define LAS __attribute__((address_space(3)))
#define GAS __attribute__((address_space(1)))
typedef unsigned short bf16;
typedef short bf16x8 __attribute__((ext_vector_type(8)));
typedef float f32x4 __attribute__((ext_vector_type(4)));
typedef float f32x2 __attribute__((ext_vector_type(2)));
typedef unsigned u32x4 __attribute__((ext_vector_type(4)));
typedef unsigned u32x2 __attribute__((ext_vector_type(2)));

constexpr int NB = 4, SEQ = 8192, D = 1024, NMETA = 16, DEPTH = 2;
constexpr int MX = NB * SEQ;
constexpr int MROWS = MX + 256;
constexpr int META0 = MX;
constexpr int DFF = 2816, INC = 4608;
constexpr int NA = 2560;
constexpr int NG = 2048;
constexpr int NGU = 2 * DFF;
constexpr float EPS = 1e-6f;

constexpr size_t A256(size_t x) { return (x + 255) & ~(size_t)255; }
constexpr size_t WS_CTL = 0, CTL_BYTES = 1u << 20;
constexpr size_t WL_INA = 0, WL_G = WL_INA + (size_t)NA * D * 2, WL_Z = WL_G + (size_t)NG * D * 2, WL_OUT = WL_Z + (size_t)D * D * 2,
                 WL_GU = WL_OUT + (size_t)D * D * 2, WL_DN = WL_GU + (size_t)NGU * D * 2, WL_BYTES = WL_DN + (size_t)D * DFF * 2;
constexpr size_t WS_W = CTL_BYTES;
constexpr size_t WS_LB = A256(WS_W + DEPTH * WL_BYTES);
constexpr size_t WS_HB = A256(WS_LB + 2 * 512 * 4);
constexpr size_t WS_HM = A256(WS_HB + (size_t)MROWS * D * 2);
constexpr size_t WS_RS = A256(WS_HM + (size_t)256 * D * 4);
constexpr size_t WS_BIG = A256(WS_RS + (size_t)MROWS * 4);
constexpr size_t B_PA = 0;
constexpr size_t B_AP = A256(B_PA + (size_t)MROWS * NA * 2);
constexpr size_t B_Z = A256(B_AP + (size_t)MROWS * D * 2);
constexpr size_t B_KV = A256(B_Z + (size_t)MROWS * D * 2);
constexpr size_t B_SS = B_KV + (size_t)256 * 16384 * 4;
constexpr size_t B_SM = B_SS + (size_t)256 * 16384 * 4;
constexpr size_t B_DD = B_SM + (size_t)4 * 16384 * 4;
constexpr size_t B_MIX_END = B_DD + (size_t)256 * 128 * 4;
constexpr size_t B_G = 0;
constexpr size_t B_U = A256(B_G + (size_t)MROWS * DFF * 2);
constexpr size_t B_FFN_END = B_U + (size_t)MROWS * DFF * 2;
constexpr size_t BIG_BYTES = B_FFN_END > B_MIX_END ? B_FFN_END : B_MIX_END;
constexpr size_t WS_END = WS_BIG + BIG_BYTES;
static_assert((size_t)MROWS * D * 4 <= (size_t)MROWS * NA * 2 && (size_t)MROWS * NG * 2 <= (size_t)MROWS * NA * 2, "Y1 / gates overlay proj_a");
static_assert((size_t)MROWS * D * 4 <= (size_t)MROWS * DFF * 2, "Y2 overlays G");
static_assert(WS_END <= 536870912ull, "d_ws map exceeds 512 MiB");

constexpr int CW_TMO = 0;
constexpr int CW_BAR = 4096;

constexpr int LDS_BYTES = 147456;
constexpr int MISC_OFF = LDS_BYTES - 256;

__device__ __forceinline__ unsigned f2bf(float f) { unsigned u = __builtin_bit_cast(unsigned, f); return (u + 0x7fffu + ((u >> 16) & 1u)) >> 16; }
__device__ __forceinline__ unsigned pk2(float lo, float hi) { return f2bf(lo) | (f2bf(hi) << 16); }
__device__ __forceinline__ float bflo(unsigned w) { return __builtin_bit_cast(float, w << 16); }
__device__ __forceinline__ float bfhi(unsigned w) { return __builtin_bit_cast(float, w & 0xffff0000u); }
__device__ __forceinline__ float fsigmoid(float x) { return 1.0f / (1.0f + __expf(-x)); }
__device__ __forceinline__ float wave_sum(float v) {
#pragma unroll
    for (int o = 1; o < 64; o <<= 1) v += __shfl_xor(v, o);
    return v;
}
#define LDS_WAIT() asm volatile("s_waitcnt lgkmcnt(0)" ::: "memory")
#define VM_WAIT() asm volatile("s_waitcnt vmcnt(0)" ::: "memory")

namespace pg8 {
#define PG8_LAS __attribute__((address_space(3)))
typedef unsigned short bf16_t;
constexpr int BM = 256, BK = 64, HALF = 128, HTB = HALF * BK * 2, STAGE_BYTES = 8 * HTB, NXCD = 8, WGM = 8, THIN_PM = 128;
__host__ __device__ __forceinline__ int lds_byte(int r, int c) { const int st = (r >> 4) * 2 + (c >> 5), rr = r & 15, cc = c & 31, ob = rr * 64 + cc * 2; return st * 1024 + (ob ^ (((ob >> 9) & 1) << 5)); }
__host__ __device__ __forceinline__ void stage_rc(int b, int& R, int& C) { const int st = b / 1024, sb = b % 1024, swz = sb ^ (((sb >> 9) & 1) << 5); R = (st >> 1) * 16 + swz / 64; C = (st & 1) * 32 + (swz % 64) / 2; }
__host__ __device__ __forceinline__ int perm32(int rho) { const int n = rho >> 4, i = rho & 15; return 8 * (i >> 2) + 4 * n + (i & 3); }

struct Unit { int pm, pn, half; };
struct Gemm { const bf16_t* A; const bf16_t* Bt; int lda, ldb, K, khalf; };

struct StaticOrder {
    int nM, nN, nwg, G, c;
    __host__ __device__ void init(int M, int N, int G_, int c_) { nM = M / BM; nN = N / BM; nwg = nM * nN; G = G_; c = c_; }
    __host__ __device__ bool tile(int i, Unit& u) const {
        const long L = (long)i * G + c; if (L >= nwg) return false;
        int wgid = (int)L; { const int q = nwg / NXCD, r = nwg % NXCD, xcd = wgid % NXCD, off = wgid / NXCD; wgid = (xcd < r ? xcd * (q + 1) : r * (q + 1) + (xcd - r) * q) + off; }
        const int nig = WGM * nN, gid = wgid / nig, fm = gid * WGM, gsz = (nM - fm) < WGM ? (nM - fm) : WGM;
        u.pm = fm + ((wgid % nig) % gsz); u.pn = (wgid % nig) / gsz; u.half = 0; return true;
    }
    __host__ __device__ bool next(int i, Unit& u) const { return tile(i, u); }
};
struct PairOrder : StaticOrder {
    __host__ __device__ bool next(int i, Unit& u) const { if (!tile(i >> 1, u)) return false; u.half = i & 1; return true; }
};

__device__ __forceinline__ unsigned cvt_pk_bf16(float lo, float hi) { unsigned r; asm volatile("v_cvt_pk_bf16_f32 %0, %1, %2" : "=v"(r) : "v"(lo), "v"(hi)); return r; }

typedef f32x4 Acc[2][2][4][2];

template <class Epi, class Sched, bool ALIGN_EPI>
__device__ __forceinline__ void gemm_phase(PG8_LAS unsigned char* lds, const Gemm g, const Sched& S, const Epi& E, const int tid) {
    const int wid = __builtin_amdgcn_readfirstlane(tid >> 6), lane = tid & 63, wr = wid >> 2, wc = wid & 3, fr = lane & 15, fq = lane >> 4;
    const int nt = g.K / BK;
    unsigned voffA[2], voffB[2];
#pragma unroll
    for (int i = 0; i < 2; ++i) { int R, C; stage_rc(tid * 16 + i * 8192, R, C); const int Rb = Epi::PERM ? ((R & ~31) + perm32(R & 31)) : R;
        voffA[i] = (unsigned)(R * g.lda + C) * 2u; voffB[i] = (unsigned)(Rb * g.ldb + C) * 2u; }
    const size_t kstep = (size_t)(BK * 2);
    const size_t hstepA = (size_t)HALF * g.lda * 2, hstepB = (size_t)HALF * g.ldb * 2;
    const unsigned ldsw = (unsigned)wid * 1024u;
    const int aoff = lds_byte(wr * 64 + fr, fq * 8), boff = lds_byte(wc * 32 + fr, fq * 8);
#define PG8_SA(b, h) (((b) * 2 + (h)) * HTB)
#define PG8_SB(b, h) ((4 + (b) * 2 + (h)) * HTB)
#define PG8_STAGE(bufoff, gbase, voff) do { _Pragma("unroll") for (int _i = 0; _i < 2; ++_i) \
        __builtin_amdgcn_global_load_lds((const unsigned*)((const char*)(gbase) + (voff)[_i]), (PG8_LAS unsigned*)(lds + (bufoff) + ldsw + _i * 8192), 16, 0, 0); } while (0)
#define PG8_LDA(dst, b, h) do { _Pragma("unroll") for (int m = 0; m < 4; ++m) _Pragma("unroll") for (int k = 0; k < 2; ++k) dst[m][k] = *(const PG8_LAS bf16x8*)(lds + PG8_SA(b, h) + aoff + m * 2048 + k * 1024); } while (0)
#define PG8_LDB(dst, b, h) do { _Pragma("unroll") for (int n = 0; n < 2; ++n) _Pragma("unroll") for (int k = 0; k < 2; ++k) dst[n][k] = *(const PG8_LAS bf16x8*)(lds + PG8_SB(b, h) + boff + n * 2048 + k * 1024); } while (0)
#define PG8_MMA(ai, bj, At, Bt) do { __builtin_amdgcn_s_setprio(1); _Pragma("unroll") for (int m = 0; m < 4; ++m) _Pragma("unroll") for (int n = 0; n < 2; ++n) _Pragma("unroll") for (int k = 0; k < 2; ++k) \
        acc[ai][bj][m][n] = __builtin_amdgcn_mfma_f32_16x16x32_bf16(Bt[n][k], At[m][k], acc[ai][bj][m][n], 0, 0, 0); __builtin_amdgcn_s_setprio(0); } while (0)
#define PG8_WAIT_V(n) asm volatile("s_waitcnt vmcnt(" #n ")" ::: "memory")
#define PG8_WAIT_L(n) asm volatile("s_waitcnt lgkmcnt(" #n ")" ::: "memory")
#define PG8_BAR __builtin_amdgcn_s_barrier()
#define PG8_SCHED __builtin_amdgcn_sched_barrier(0)
#define PG8_UA(u) ((const char*)g.A + (size_t)(u).pm * 2 * hstepA + (size_t)(u).half * g.khalf * 2)
#define PG8_UB(u) ((const char*)g.Bt + (size_t)(u).pn * 2 * hstepB + (size_t)(u).half * g.khalf * 2)
    Unit cur, nxt; int ui = 0;
    if (!S.next(0, cur)) return;
    Acc acc;
#pragma unroll
    for (int a = 0; a < 2; ++a)
#pragma unroll
        for (int b = 0; b < 2; ++b)
#pragma unroll
            for (int m = 0; m < 4; ++m)
#pragma unroll
                for (int n = 0; n < 2; ++n) acc[a][b][m][n] = (f32x4){0.f, 0.f, 0.f, 0.f};
    bf16x8 At[4][2], B0[2][2], B1[2][2];
    const char* cA = PG8_UA(cur); const char* cB = PG8_UB(cur);
    PG8_STAGE(PG8_SB(0, 0), cB, voffB); PG8_STAGE(PG8_SB(0, 1), cB + hstepB, voffB); PG8_STAGE(PG8_SA(0, 0), cA, voffA); PG8_STAGE(PG8_SA(0, 1), cA + hstepA, voffA);
    if (wr == 1) PG8_BAR;
    PG8_WAIT_V(2); PG8_BAR;
    PG8_STAGE(PG8_SB(1, 0), cB + kstep, voffB); PG8_STAGE(PG8_SA(1, 0), cA + kstep, voffA); PG8_STAGE(PG8_SB(1, 1), cB + hstepB + kstep, voffB);
    PG8_WAIT_V(6); PG8_BAR;
    for (;;) {
        const bool has_next = S.next(ui + 1, nxt);
        const char* nA = has_next ? PG8_UA(nxt) : cA; const char* nB = has_next ? PG8_UB(nxt) : cB;
        for (int t = 0; t < nt; t += 2) {
            const bool last = (t == nt - 2);
            const char* a1 = cA + (size_t)(t + 1) * kstep;
            const char* a2 = last ? nA : cA + (size_t)(t + 2) * kstep; const char* b2 = last ? nB : cB + (size_t)(t + 2) * kstep;
            const char* a3 = a2 + kstep; const char* b3 = b2 + kstep;
            PG8_LDB(B0, 0, 0); PG8_LDB(B1, 0, 1); PG8_SCHED; PG8_LDA(At, 0, 0); PG8_STAGE(PG8_SA(1, 1), a1 + hstepA, voffA);
            PG8_WAIT_V(8); PG8_WAIT_L(0); PG8_BAR; PG8_MMA(0, 0, At, B0); PG8_MMA(0, 1, At, B1); PG8_BAR; PG8_SCHED;
            PG8_LDA(At, 0, 1); PG8_STAGE(PG8_SB(0, 0), b2, voffB); PG8_STAGE(PG8_SB(0, 1), b2 + hstepB, voffB); PG8_STAGE(PG8_SA(0, 0), a2, voffA);
            PG8_WAIT_V(8); PG8_WAIT_L(0); PG8_BAR; PG8_MMA(1, 0, At, B0); PG8_MMA(1, 1, At, B1); PG8_BAR; PG8_SCHED;
            PG8_LDB(B0, 1, 0); PG8_LDB(B1, 1, 1); PG8_SCHED; PG8_LDA(At, 1, 0); PG8_STAGE(PG8_SA(0, 1), a2 + hstepA, voffA);
            PG8_WAIT_V(8); PG8_WAIT_L(0); PG8_BAR; PG8_MMA(0, 0, At, B0); PG8_MMA(0, 1, At, B1); PG8_BAR; PG8_SCHED;
            PG8_LDA(At, 1, 1); PG8_STAGE(PG8_SB(1, 0), b3, voffB); PG8_STAGE(PG8_SB(1, 1), b3 + hstepB, voffB); PG8_STAGE(PG8_SA(1, 0), a3, voffA);
            PG8_WAIT_V(8); PG8_WAIT_L(0); PG8_BAR; PG8_MMA(1, 0, At, B0); PG8_MMA(1, 1, At, B1); PG8_BAR; PG8_SCHED;
        }
        if constexpr (ALIGN_EPI) { if (wr == 0) PG8_BAR; }
        E(acc, cur, wr, wc, fr, fq);
        if (!has_next) break;
        if (!E.keep(cur)) {
#pragma unroll
            for (int a = 0; a < 2; ++a)
#pragma unroll
                for (int b = 0; b < 2; ++b)
#pragma unroll
                    for (int m = 0; m < 4; ++m)
#pragma unroll
                        for (int n = 0; n < 2; ++n) acc[a][b][m][n] = (f32x4){0.f, 0.f, 0.f, 0.f};
        }
        cur = nxt; cA = nA; cB = nB; ++ui;
        if constexpr (ALIGN_EPI) { if (wr == 1) PG8_BAR; }
    }
    PG8_WAIT_V(0);
    if constexpr (!ALIGN_EPI) { if (wr == 0) PG8_BAR; }
    PG8_BAR;
#undef PG8_SA
#undef PG8_SB
#undef PG8_STAGE
#undef PG8_LDA
#undef PG8_LDB
#undef PG8_MMA
#undef PG8_WAIT_V
#undef PG8_WAIT_L
#undef PG8_BAR
#undef PG8_SCHED
#undef PG8_UA
#undef PG8_UB
}

struct EpiProjA {
    static constexpr bool PERM = true;
    bf16_t* O; const float* rs;
    __device__ __forceinline__ bool keep(const Unit&) const { return false; }
    __device__ __forceinline__ void operator()(Acc& acc, const Unit& u, int wr, int wc, int fr, int fq) const {
        const int row0 = u.pm * BM + wr * 64 + fr, col0 = u.pn * BM + wc * 32 + 8 * fq;
        const bool sig = (u.pn == 6 || u.pn == 7);
#pragma unroll
        for (int ai = 0; ai < 2; ++ai)
#pragma unroll
            for (int m = 0; m < 4; ++m) { const int r = row0 + ai * HALF + m * 16; const float s = rs[r]; bf16_t* rowp = O + (size_t)r * NA + col0;
#pragma unroll
                for (int bj = 0; bj < 2; ++bj) { f32x4 v0 = acc[ai][bj][m][0] * s, v1 = acc[ai][bj][m][1] * s;
                    if (sig) {
#pragma unroll
                        for (int e = 0; e < 4; ++e) { v0[e] = fsigmoid(v0[e]); v1[e] = fsigmoid(v1[e]); } }
                    u32x4 w; w.x = cvt_pk_bf16(v0[0], v0[1]); w.y = cvt_pk_bf16(v0[2], v0[3]); w.z = cvt_pk_bf16(v1[0], v1[1]); w.w = cvt_pk_bf16(v1[2], v1[3]);
                    *(u32x4*)(rowp + bj * HALF) = w; } }
    }
};
struct EpiGates {
    static constexpr bool PERM = true;
    bf16_t* O; const float* rs;
    __device__ __forceinline__ bool keep(const Unit&) const { return false; }
    __device__ __forceinline__ void operator()(Acc& acc, const Unit& u, int wr, int wc, int fr, int fq) const {
        const int row0 = u.pm * BM + wr * 64 + fr, col0 = u.pn * HALF + wc * 32 + 8 * fq;
#pragma unroll
        for (int ai = 0; ai < 2; ++ai)
#pragma unroll
            for (int m = 0; m < 4; ++m) { const int r = row0 + ai * HALF + m * 16; const float s = rs[r]; bf16_t* rowp = O + (size_t)r * NG + col0;
                float R[8], SB[8];
#pragma unroll
                for (int n = 0; n < 2; ++n)
#pragma unroll
                    for (int e = 0; e < 4; ++e) { const float ga = acc[ai][0][m][n][e] * s, gb = acc[ai][1][m][n][e] * s;
                        const float ea = __expf(-ga), eb = __expf(-gb); const float sb = 1.0f / (1.0f + eb);
                        SB[n * 4 + e] = sb; R[n * 4 + e] = (1.0f + eb) / (1.0f + ea); }
                u32x4 w; w.x = cvt_pk_bf16(R[0], R[1]); w.y = cvt_pk_bf16(R[2], R[3]); w.z = cvt_pk_bf16(R[4], R[5]); w.w = cvt_pk_bf16(R[6], R[7]);
                *(u32x4*)(rowp) = w;
                w.x = cvt_pk_bf16(SB[0], SB[1]); w.y = cvt_pk_bf16(SB[2], SB[3]); w.z = cvt_pk_bf16(SB[4], SB[5]); w.w = cvt_pk_bf16(SB[6], SB[7]);
                *(u32x4*)(rowp + 1024) = w; }
    }
};
struct EpiZ {
    static constexpr bool PERM = true;
    const bf16_t* GT; bf16_t* Z;
    __device__ __forceinline__ bool keep(const Unit& u) const { return u.half == 0; }
    __device__ __forceinline__ void operator()(Acc& acc, const Unit& u, int wr, int wc, int fr, int fq) const {
        const int row0 = u.pm * BM + wr * 64 + fr, col0 = u.pn * BM + wc * 32 + 8 * fq;
        const int goff = (u.half == 0) ? 0 : 1024;
#pragma unroll
        for (int ai = 0; ai < 2; ++ai)
#pragma unroll
            for (int m = 0; m < 4; ++m) { const int r = row0 + ai * HALF + m * 16;
#pragma unroll
                for (int bj = 0; bj < 2; ++bj) { const u32x4 gw = *(const u32x4*)(GT + (size_t)r * NG + goff + col0 + bj * HALF);
                    const f32x4 g0 = (f32x4){bflo(gw.x), bfhi(gw.x), bflo(gw.y), bfhi(gw.y)}, g1 = (f32x4){bflo(gw.z), bfhi(gw.z), bflo(gw.w), bfhi(gw.w)};
                    const f32x4 v0 = acc[ai][bj][m][0] * g0, v1 = acc[ai][bj][m][1] * g1;
                    if (u.half == 0) { acc[ai][bj][m][0] = v0; acc[ai][bj][m][1] = v1; }
                    else { u32x4 w; w.x = cvt_pk_bf16(v0[0], v0[1]); w.y = cvt_pk_bf16(v0[2], v0[3]); w.z = cvt_pk_bf16(v1[0], v1[1]); w.w = cvt_pk_bf16(v1[2], v1[3]);
                        *(u32x4*)(Z + (size_t)r * D + col0 + bj * HALF) = w; } } }
    }
};
struct EpiF32 {
    static constexpr bool PERM = false;
    float* C; int ldc;
    __device__ __forceinline__ bool keep(const Unit&) const { return false; }
    __device__ __forceinline__ void operator()(Acc& acc, const Unit& u, int wr, int wc, int fr, int fq) const {
        const int row0 = u.pm * BM + wr * 64 + fr, col0 = u.pn * BM + wc * 32 + 4 * fq;
#pragma unroll
        for (int ai = 0; ai < 2; ++ai)
#pragma unroll
            for (int m = 0; m < 4; ++m) { float* rowp = C + (size_t)(row0 + ai * HALF + m * 16) * ldc + col0;
#pragma unroll
                for (int bj = 0; bj < 2; ++bj)
#pragma unroll
                    for (int n = 0; n < 2; ++n) *(f32x4*)(rowp + bj * HALF + n * 16) = acc[ai][bj][m][n]; }
    }
};
struct EpiGU {
    static constexpr bool PERM = true;
    bf16_t* G; bf16_t* U; const float* rs;
    __device__ __forceinline__ bool keep(const Unit&) const { return false; }
    __device__ __forceinline__ void operator()(Acc& acc, const Unit& u, int wr, int wc, int fr, int fq) const {
        const int row0 = u.pm * BM + wr * 64 + fr, col0 = u.pn * HALF + wc * 32 + 8 * fq;
#pragma unroll
        for (int ai = 0; ai < 2; ++ai)
#pragma unroll
            for (int m = 0; m < 4; ++m) { const int r = row0 + ai * HALF + m * 16; const float s = rs[r];
#pragma unroll
                for (int bj = 0; bj < 2; ++bj) { const f32x4 v0 = acc[ai][bj][m][0] * s, v1 = acc[ai][bj][m][1] * s;
                    u32x4 w; w.x = cvt_pk_bf16(v0[0], v0[1]); w.y = cvt_pk_bf16(v0[2], v0[3]); w.z = cvt_pk_bf16(v1[0], v1[1]); w.w = cvt_pk_bf16(v1[2], v1[3]);
                    *(u32x4*)((bj == 0 ? G : U) + (size_t)r * DFF + col0) = w; } }
    }
};
}

#define XB_TMO      128
#define XB_XCNT(j)  (256  + 64 * (j))
#define XB_XSUB(j)  (1280 + 64 * (j))
#define XB_XGEN(j)  (2304 + 64 * (j))
#define XB_TOP      3328
#define XB_TOPGEN   3392
#define XCD_BAR_WORDS 3456
#define XB_SPIN_CAP (1u << 18)
__device__ __forceinline__ unsigned xb_ld(unsigned* p)              { return __hip_atomic_load(p, __ATOMIC_RELAXED, __HIP_MEMORY_SCOPE_AGENT); }
__device__ __forceinline__ unsigned xb_add(unsigned* p, unsigned v) { return __hip_atomic_fetch_add(p, v, __ATOMIC_RELAXED, __HIP_MEMORY_SCOPE_AGENT); }
__device__ __forceinline__ unsigned xb_xcc_id() { return (unsigned)__builtin_amdgcn_s_getreg((3 << 11) | 20) & 0xFu; }
#define XB_SPIN(cond, bar) do { unsigned _sp = 0; while (cond) { __builtin_amdgcn_s_sleep(1); \
    if ((++_sp & 255u) == 0u) { if (xb_ld(&(bar)[XB_TMO])) break; if (_sp > XB_SPIN_CAP) { atomicAdd(&(bar)[XB_TMO], 1u); break; } } } } while (0)
struct XcdBarrier { unsigned* bar; unsigned x; volatile LAS unsigned* st; };
__device__ __forceinline__ XcdBarrier xcd_barrier_post(unsigned* bar, volatile LAS unsigned* st) {
    XcdBarrier b; b.bar = bar; b.x = xb_xcc_id(); b.st = st;
    if (threadIdx.x == 0) (void)xb_add(&bar[XB_XCNT(b.x)], 1u);
    return b;
}
__device__ __forceinline__ void xcd_barrier_complete(unsigned* bar, unsigned x, unsigned& nloc, unsigned& nx) {
    const unsigned G = gridDim.x * gridDim.y * gridDim.z;
    unsigned sum, cnt, mine, sp = 0u;
    for (;;) {
        sum = 0u; cnt = 0u; mine = 0u;
#pragma unroll
        for (unsigned j = 0; j < 16; ++j) { const unsigned c = xb_ld(&bar[XB_XCNT(j)]); sum += c; cnt += (c > 0u) ? 1u : 0u; mine = (j == x) ? c : mine; }
        if (sum == G) break;
        __builtin_amdgcn_s_sleep(1);
        if ((++sp & 255u) == 0u) { if (xb_ld(&bar[XB_TMO])) break; if (sp > XB_SPIN_CAP) { atomicAdd(&bar[XB_TMO], 1u); break; } }
    }
    nloc = mine > 0u ? mine : 1u; nx = cnt > 0u ? cnt : 1u;
}
__device__ __forceinline__ void xcd_barrier(const XcdBarrier& b) {
    asm volatile("s_waitcnt vmcnt(0)" ::: "memory");
    __syncthreads();
    if (threadIdx.x == 0) {
        unsigned* bar = b.bar;
        __builtin_amdgcn_s_waitcnt(0);
        unsigned nloc = b.st[0], nx = b.st[1];
        if (nloc == 0u) { xcd_barrier_complete(bar, b.x, nloc, nx); b.st[0] = nloc; b.st[1] = nx; }
        const unsigned old = xb_add(&bar[XB_XSUB(b.x)], 1u);
        const unsigned gen = old / nloc;
        if (old + 1u == (gen + 1u) * nloc) {
            __builtin_amdgcn_fence(__ATOMIC_RELEASE, "agent");
            asm volatile("s_waitcnt vmcnt(0)" ::: "memory");
            const unsigned og = xb_add(&bar[XB_TOP], 1u);
            const unsigned tg = og / nx;
            if (og + 1u == (tg + 1u) * nx) xb_add(&bar[XB_TOPGEN], 1u);
            else XB_SPIN(xb_ld(&bar[XB_TOPGEN]) == tg, bar);
            __builtin_amdgcn_fence(__ATOMIC_ACQUIRE, "agent");
            xb_add(&bar[XB_XGEN(b.x)], 1u);
            asm volatile("s_waitcnt vmcnt(0)" ::: "memory");
        } else {
            XB_SPIN(xb_ld(&bar[XB_XGEN(b.x)]) == gen, bar);
            __builtin_amdgcn_fence(__ATOMIC_ACQUIRE, "agent");
            asm volatile("s_waitcnt vmcnt(0)" ::: "memory");
        }
    }
    __syncthreads();
}

struct Args { const float* in[19]; float* out; unsigned char* ws; int ph_lo, ph_hi, li, pad; };
struct Frame {
    LAS unsigned char* lds;
    int tid, lane, wave, vcu, G, bx;
    float* out; unsigned char* ws;
};
__device__ __forceinline__ float* hrow_ptr(const Frame& F, int r) { return r < MX ? F.out + (size_t)r * D : (float*)(F.ws + WS_HM) + (size_t)(r - MX) * D; }
__device__ __forceinline__ int prev_row(int r, int j) {
    if (r < MX) { const int t = r & (SEQ - 1); if (t >= j) return r - j; const int m = NMETA + t - j; return m >= 0 ? META0 + m : -1; }
    const int m = r - META0 - j; return m >= 0 ? META0 + m : -1;
}

__device__ __forceinline__ void tr_store(LAS float* scr, bf16* dst, int ldd, int n0d, int kd0, int lane) {
    LDS_WAIT(); asm volatile("" ::: "memory");
    const int c = lane & 7;
#pragma unroll
    for (int j = 0; j < 4; ++j) { const int n = (lane >> 3) + 8 * j; const LAS float* s = scr + (8 * c) * 33 + n;
        u32x4 o; o.x = pk2(s[0 * 33], s[1 * 33]); o.y = pk2(s[2 * 33], s[3 * 33]); o.z = pk2(s[4 * 33], s[5 * 33]); o.w = pk2(s[6 * 33], s[7 * 33]);
        *(u32x4*)(dst + (size_t)(n0d + n) * ldd + kd0 + 8 * c) = o; }
    LDS_WAIT(); asm volatile("" ::: "memory");
}
__device__ __forceinline__ void tr_item(const float* src, int lds_, int n0s, int k0, const float* gain, bf16* dst, int ldd, int n0d, int kd0, LAS float* scr, int lane) {
#pragma unroll 8
    for (int i = 0; i < 32; ++i) { const int kk = 2 * i + (lane >> 5); float v = src[(size_t)(k0 + kk) * lds_ + n0s + (lane & 31)]; if (gain) v *= gain[k0 + kk]; scr[kk * 33 + (lane & 31)] = v; }
    tr_store(scr, dst, ldd, n0d, kd0, lane);
}
__device__ __forceinline__ void wp_item(const float* pp, const float* ps, const float* wbp, int k0, int n0, bf16* dst, int ldd, int kd0, LAS float* scr, int lane) {
    const int g = k0 >> 7, c0 = (k0 & 127) + 32 * (lane >> 5), n = n0 + (lane & 31);
    float acc[32];
#pragma unroll
    for (int i = 0; i < 32; ++i) acc[i] = 0.f;
    const float* ppg = pp + (size_t)g * 128 * 128 + (size_t)c0 * 128;
    for (int d = 0; d < 128; ++d) { const float x = ps[g * 128 + d] * wbp[(size_t)(g * 128 + d) * D + n];
#pragma unroll
        for (int i = 0; i < 32; ++i) acc[i] += ppg[i * 128 + d] * x; }
#pragma unroll
    for (int i = 0; i < 32; ++i) scr[(32 * (lane >> 5) + i) * 33 + (lane & 31)] = acc[i];
    tr_store(scr, dst, ldd, n0, kd0, lane);
}
__device__ __forceinline__ void phase_prologue(Frame& F, const Args& A) {
    LAS float* scr = (LAS float*)(F.lds + F.wave * 16384);
    const int gw = F.vcu * 8 + F.wave, NGW = F.G * 8;
    constexpr int I_INA = 16 * (NA / 32), I_G = 16 * (NG / 32), I_ZH = 8 * 32, I_ZP = 8 * 32, I_OUT = 16 * 32, I_GU = 16 * (NGU / 32), I_DN = (DFF / 64) * 32;
    constexpr int I_LAYER = I_INA + I_G + I_ZH + I_ZP + I_OUT + I_GU + I_DN;
    for (int it = gw; it < DEPTH * I_LAYER; it += NGW) {
        const int l = it / I_LAYER; int r = it % I_LAYER;
        bf16* W = (bf16*)(F.ws + WS_W + (size_t)l * WL_BYTES);
        if (r < I_INA) { const int nblk = NA / 32, kb = r / nblk, nb = r % nblk;
            tr_item(A.in[4] + (size_t)l * D * INC, INC, 32 * nb, 64 * kb, A.in[2] + l * D, (bf16*)((char*)W + WL_INA), D, 32 * nb, 64 * kb, scr, F.lane); continue; } r -= I_INA;
        if (r < I_G) { const int nblk = NG / 32, kb = r / nblk, nb = r % nblk, n0d = 32 * nb, p = n0d >> 8, j = n0d & 255;
            const int n0s = (j < 128) ? (2560 + 128 * p + j) : (3584 + 128 * p + (j - 128));
            tr_item(A.in[4] + (size_t)l * D * INC, INC, n0s, 64 * kb, A.in[2] + l * D, (bf16*)((char*)W + WL_G), D, n0d, 64 * kb, scr, F.lane); continue; } r -= I_G;
        if (r < I_ZH) { const int kb = r / 32, nb = r % 32;
            tr_item(A.in[7] + (size_t)l * 512 * D, D, 32 * nb, 64 * kb, A.in[6] + l * 512, (bf16*)((char*)W + WL_Z), D, 32 * nb, 64 * kb, scr, F.lane); continue; } r -= I_ZH;
        if (r < I_ZP) { const int kb = r / 32, nb = r % 32;
            wp_item(A.in[8] + (size_t)l * 4 * 128 * 128, A.in[9] + l * 512, A.in[10] + (size_t)l * 512 * D, 64 * kb, 32 * nb, (bf16*)((char*)W + WL_Z), D, 512 + 64 * kb, scr, F.lane); continue; } r -= I_ZP;
        if (r < I_OUT) { const int kb = r / 32, nb = r % 32;
            tr_item(A.in[11] + (size_t)l * D * D, D, 32 * nb, 64 * kb, nullptr, (bf16*)((char*)W + WL_OUT), D, 32 * nb, 64 * kb, scr, F.lane); continue; } r -= I_OUT;
        if (r < I_GU) { const int nblk = NGU / 32, kb = r / nblk, nb = r % nblk, n0d = 32 * nb, p = n0d >> 8, j = n0d & 255;
            const float* src = (j < 128 ? A.in[14] : A.in[15]) + (size_t)l * D * DFF;
            tr_item(src, DFF, 128 * p + (j & 127), 64 * kb, A.in[12] + l * D, (bf16*)((char*)W + WL_GU), D, n0d, 64 * kb, scr, F.lane); continue; } r -= I_GU;
        { const int kb = r / 32, nb = r % 32;
            tr_item(A.in[18] + (size_t)l * DFF * D, D, 32 * nb, 64 * kb, nullptr, (bf16*)((char*)W + WL_DN), DFF, 32 * nb, 64 * kb, scr, F.lane); }
    }
    bf16* HB = (bf16*)(F.ws + WS_HB); float* RS = (float*)(F.ws + WS_RS);
    for (int r = gw; r < MROWS; r += NGW) {
        f32x4 v[4];
        if (r < MX) {
#pragma unroll
            for (int j = 0; j < 4; ++j) v[j] = *((const f32x4*)(A.in[0] + (size_t)r * D) + F.lane + 64 * j);
        } else if (r < MX + NMETA) {
#pragma unroll
            for (int j = 0; j < 4; ++j) v[j] = *((const f32x4*)(A.in[1] + (size_t)(r - MX) * D) + F.lane + 64 * j);
        } else {
#pragma unroll
            for (int j = 0; j < 4; ++j) v[j] = (f32x4){0.f, 0.f, 0.f, 0.f};
        }
        float ss = 0.f;
#pragma unroll
        for (int j = 0; j < 4; ++j) ss += (v[j].x * v[j].x + v[j].y * v[j].y) + (v[j].z * v[j].z + v[j].w * v[j].w);
        ss = wave_sum(ss);
        float* hp = hrow_ptr(F, r);
#pragma unroll
        for (int j = 0; j < 4; ++j) { if (r >= MX) *((f32x4*)hp + F.lane + 64 * j) = v[j];
            u32x2 w; w.x = pk2(v[j].x, v[j].y); w.y = pk2(v[j].z, v[j].w); *((u32x2*)(HB + (size_t)r * D) + F.lane + 64 * j) = w; }
        if (F.lane == 0) RS[r] = 1.0f / sqrtf(ss * (1.0f / D) + EPS);
    }
    if (blockIdx.x == 0) { float* LB = (float*)(F.ws + WS_LB);
        for (int k = F.tid; k < 512; k += 512) { const float x0 = A.in[5][k], x1 = A.in[5][512 + k]; const float mx = fmaxf(x0, x1), e0 = __expf(x0 - mx), e1 = __expf(x1 - mx);
            const float g0 = e0 / (e0 + e1), g1 = e1 / (e0 + e1); float lb1 = (g0 + g1) - g0; lb1 = fminf(fmaxf(lb1, 0.f), 1.f); LB[k] = 0.f; LB[512 + k] = lb1; } }
}

namespace hg {
constexpr int SQ = 136, S72 = 72;
constexpr int L_QS = 0, L_QD = L_QS + 64 * SQ * 2, L_KS = L_QD + 64 * SQ * 2, L_KDT = L_KS + 64 * SQ * 2, L_VT = L_KDT + 128 * S72 * 2, L_P = L_VT + 128 * S72 * 2,
              L_ST = L_P + 64 * S72 * 2, L_CP = L_ST + 128 * SQ * 2, L_DL = L_CP + 8 * 128 * 4, L_RSS = L_DL + 128 * 4, L_END = L_RSS + 2 * 64 * 4;
static_assert(L_END <= MISC_OFF, "hgrn LDS");
__device__ __forceinline__ f32x4 mfma16(bf16x8 a, bf16x8 b, f32x4 c) { return __builtin_amdgcn_mfma_f32_16x16x32_bf16(a, b, c, 0, 0, 0); }
#define HG_BAR() do { asm volatile("s_waitcnt lgkmcnt(0)" ::: "memory"); __builtin_amdgcn_s_barrier(); asm volatile("" ::: "memory"); } while (0)

struct CIn { unsigned qw[8], fw[8]; u32x4 va, vb; };
template <bool NEEDQ>
__device__ __forceinline__ void load_cin(CIn& c, const bf16* PA, int r0, int h, int nvalid, int w, int lane) {
#pragma unroll
    for (int j = 0; j < 8; ++j) { const int t = 8 * w + j; const bf16* rowp = PA + (size_t)(r0 + t) * NA + h * 128 + 2 * lane;
        c.fw[j] = (t < nvalid) ? *(const unsigned*)(rowp + 512) : 0u;
        c.qw[j] = (NEEDQ && t < nvalid) ? *(const unsigned*)rowp : 0u; }
    const u32x4 z = (u32x4){0u, 0u, 0u, 0u}; c.va = z; c.vb = z;
    if (lane < nvalid) { const bf16* vp = PA + (size_t)(r0 + lane) * NA + 1024 + h * 128 + 16 * w; c.va = *(const u32x4*)vp; c.vb = *(const u32x4*)(vp + 8); }
}
__device__ __forceinline__ void load_sg(u32x2 (&sg)[4], const bf16* PA, int r0, int h, int nvalid, int w, int lane) {
    const int t = (w & 3) * 16 + (lane & 15), ch = w >> 2, fq = lane >> 4;
#pragma unroll
    for (int i = 0; i < 4; ++i) sg[i] = (t < nvalid) ? *(const u32x2*)(PA + (size_t)(r0 + t) * NA + 1536 + h * 128 + (ch * 4 + i) * 16 + 4 * fq) : (u32x2){0u, 0u};
}
__device__ __forceinline__ void fgate(float fl, float lb, bool valid, float& lf, float& kk) {
    const float e = __expf(-fabsf(fl)), sp = 1.0f / (1.0f + e), sn = e * sp; const float sg = fl >= 0.f ? sp : sn, sgn = fl >= 0.f ? sn : sp;
    const float f = lb + (1.0f - lb) * sg; lf = valid ? __logf(fmaxf(f, 1e-30f)) : 0.f; kk = valid ? (1.0f - lb) * sgn : 0.f;
}
__device__ __forceinline__ void write_vt(LAS bf16* VT, const CIn& c, int w, int lane) {
    const unsigned vv[8] = {c.va.x, c.va.y, c.va.z, c.va.w, c.vb.x, c.vb.y, c.vb.z, c.vb.w};
#pragma unroll
    for (int j = 0; j < 8; ++j) { VT[(16 * w + 2 * j) * S72 + lane] = (bf16)(vv[j] & 0xffffu); VT[(16 * w + 2 * j + 1) * S72 + lane] = (bf16)(vv[j] >> 16); }
}

__device__ __forceinline__ void chunk_a(LAS unsigned char* lds, const CIn& c, int nvalid, float lb0, float lb1, float& carry0, float& carry1, f32x4 (&Sacc)[8], int w, int lane) {
    asm volatile("" : "+v"(lane)); asm volatile("" : "+s"(w));
    const int fr = lane & 15, fq = lane >> 4, k0 = 2 * lane;
    LAS bf16* KDT = (LAS bf16*)(lds + L_KDT); LAS bf16* VT = (LAS bf16*)(lds + L_VT); LAS float* CP = (LAS float*)(lds + L_CP);
    float c0[8], c1[8], kk0[8], kk1[8]; float run0 = 0.f, run1 = 0.f;
#pragma unroll
    for (int j = 0; j < 8; ++j) { const bool valid = (8 * w + j) < nvalid; float lf;
        fgate(bflo(c.fw[j]), lb0, valid, lf, kk0[j]); run0 += lf; c0[j] = run0;
        fgate(bfhi(c.fw[j]), lb1, valid, lf, kk1[j]); run1 += lf; c1[j] = run1; }
    CP[w * 128 + k0] = run0; CP[w * 128 + k0 + 1] = run1;
    HG_BAR();
    float pre0 = 0.f, pre1 = 0.f, tot0 = 0.f, tot1 = 0.f;
#pragma unroll
    for (int ww = 0; ww < 8; ++ww) { const float x0 = CP[ww * 128 + k0], x1 = CP[ww * 128 + k0 + 1]; if (ww < w) { pre0 += x0; pre1 += x1; } tot0 += x0; tot1 += x1; }
    {
        unsigned kd0[4], kd1[4];
#pragma unroll
        for (int j = 0; j < 8; ++j) { const float kdv0 = kk0[j] * __expf(carry0 + tot0 - (pre0 + c0[j])), kdv1 = kk1[j] * __expf(carry1 + tot1 - (pre1 + c1[j]));
            if (j & 1) { kd0[j >> 1] |= f2bf(kdv0) << 16; kd1[j >> 1] |= f2bf(kdv1) << 16; } else { kd0[j >> 1] = f2bf(kdv0); kd1[j >> 1] = f2bf(kdv1); } }
        *(LAS u32x4*)(KDT + k0 * S72 + 8 * w) = (u32x4){kd0[0], kd0[1], kd0[2], kd0[3]};
        *(LAS u32x4*)(KDT + (k0 + 1) * S72 + 8 * w) = (u32x4){kd1[0], kd1[1], kd1[2], kd1[3]};
    }
    carry0 += tot0; carry1 += tot1;
    write_vt(VT, c, w, lane);
    HG_BAR();
    bf16x8 a[2];
#pragma unroll
    for (int ks = 0; ks < 2; ++ks) a[ks] = *(const LAS bf16x8*)(KDT + (16 * w + fr) * S72 + ks * 32 + 8 * fq);
#pragma unroll
    for (int cb = 0; cb < 8; ++cb) { f32x4 s = Sacc[cb];
#pragma unroll
        for (int ks = 0; ks < 2; ++ks) { const bf16x8 b = *(const LAS bf16x8*)(VT + (cb * 16 + fr) * S72 + ks * 32 + 8 * fq); s = mfma16(a[ks], b, s); }
        Sacc[cb] = s; }
}

__device__ __forceinline__ void chunk_c(LAS unsigned char* lds, const CIn& c, const bf16* PA, bf16* AP, int r0, int h, int nvalid, float lb0, float lb1, f32x4 (&Sacc)[8], int w, int lane) {
    asm volatile("" : "+v"(lane)); asm volatile("" : "+s"(w));
    const int fr = lane & 15, fq = lane >> 4, k0 = 2 * lane;

    LAS bf16* QS = (LAS bf16*)(lds + L_QS); LAS bf16* QD = (LAS bf16*)(lds + L_QD); LAS bf16* KS = (LAS bf16*)(lds + L_KS);
    LAS bf16* KDT = (LAS bf16*)(lds + L_KDT); LAS bf16* VT = (LAS bf16*)(lds + L_VT); LAS bf16* P = (LAS bf16*)(lds + L_P); LAS bf16* ST = (LAS bf16*)(lds + L_ST);
    LAS float* CP = (LAS float*)(lds + L_CP); LAS float* DL = (LAS float*)(lds + L_DL); LAS float* RSS = (LAS float*)(lds + L_RSS);
    float c0[8], c1[8], kk0[8], kk1[8]; float run0 = 0.f, run1 = 0.f;
#pragma unroll
    for (int j = 0; j < 8; ++j) { const bool valid = (8 * w + j) < nvalid; float lf;
        fgate(bflo(c.fw[j]), lb0, valid, lf, kk0[j]); run0 += lf; c0[j] = run0;
        fgate(bfhi(c.fw[j]), lb1, valid, lf, kk1[j]); run1 += lf; c1[j] = run1; }
    CP[w * 128 + k0] = run0; CP[w * 128 + k0 + 1] = run1;
#pragma unroll
    for (int cb = 0; cb < 8; ++cb) { u32x2 wv; wv.x = pk2(Sacc[cb][0], Sacc[cb][1]); wv.y = pk2(Sacc[cb][2], Sacc[cb][3]);
        *(LAS u32x2*)(ST + (cb * 16 + fr) * SQ + 16 * w + 4 * fq) = wv; }
    write_vt(VT, c, w, lane);
    HG_BAR();
    float pre0 = 0.f, pre1 = 0.f, tot0 = 0.f, tot1 = 0.f, mid0 = 0.f, mid1 = 0.f;
#pragma unroll
    for (int ww = 0; ww < 8; ++ww) { const float x0 = CP[ww * 128 + k0], x1 = CP[ww * 128 + k0 + 1];
        if (ww < w) { pre0 += x0; pre1 += x1; } if (ww < 4) { mid0 += x0; mid1 += x1; } tot0 += x0; tot1 += x1; }
    {
        unsigned kd0[4], kd1[4];
#pragma unroll
        for (int j = 0; j < 8; ++j) { const int t = 8 * w + j;
            const float b0 = pre0 + c0[j], b1 = pre1 + c1[j], q0 = bflo(c.qw[j]), q1 = bfhi(c.qw[j]);
            const float qd0 = q0 * __expf(b0), qd1 = q1 * __expf(b1);
            const float qs0 = q0 * __expf(fminf(b0 - mid0, 80.f)), qs1 = q1 * __expf(fminf(b1 - mid1, 80.f));
            const float ks0 = kk0[j] * __expf(fminf(mid0 - b0, 80.f)), ks1 = kk1[j] * __expf(fminf(mid1 - b1, 80.f));
            const float kdv0 = kk0[j] * __expf(tot0 - b0), kdv1 = kk1[j] * __expf(tot1 - b1);
            *(LAS unsigned*)(QD + t * SQ + k0) = pk2(qd0, qd1);
            *(LAS unsigned*)(QS + t * SQ + k0) = pk2(qs0, qs1);
            *(LAS unsigned*)(KS + t * SQ + k0) = pk2(ks0, ks1);
            if (j & 1) { kd0[j >> 1] |= f2bf(kdv0) << 16; kd1[j >> 1] |= f2bf(kdv1) << 16; } else { kd0[j >> 1] = f2bf(kdv0); kd1[j >> 1] = f2bf(kdv1); }
        }
        *(LAS u32x4*)(KDT + k0 * S72 + 8 * w) = (u32x4){kd0[0], kd0[1], kd0[2], kd0[3]};
        *(LAS u32x4*)(KDT + (k0 + 1) * S72 + 8 * w) = (u32x4){kd1[0], kd1[1], kd1[2], kd1[3]};
    }
    if (w == 0) { DL[k0] = __expf(tot0); DL[k0 + 1] = __expf(tot1); }
    u32x2 sgv[4]; load_sg(sgv, PA, r0, h, nvalid, w, lane);
    HG_BAR();
    {
        const int tb = w >> 1;
#pragma unroll
        for (int blk = 0; blk < 2; ++blk) { const int sb = 2 * (w & 1) + blk; f32x4 acc = (f32x4){0.f, 0.f, 0.f, 0.f};
            if (sb <= tb) {
#pragma unroll
                for (int ks = 0; ks < 4; ++ks) { const bf16x8 a = *(const LAS bf16x8*)(KS + (sb * 16 + fr) * SQ + ks * 32 + 8 * fq); const bf16x8 b = *(const LAS bf16x8*)(QS + (tb * 16 + fr) * SQ + ks * 32 + 8 * fq);
                    acc = mfma16(a, b, acc); } }
            const int t = tb * 16 + fr, s0 = sb * 16 + 4 * fq;
            u32x2 wv; wv.x = pk2(s0 + 0 <= t ? acc[0] : 0.f, s0 + 1 <= t ? acc[1] : 0.f); wv.y = pk2(s0 + 2 <= t ? acc[2] : 0.f, s0 + 3 <= t ? acc[3] : 0.f);
            *(LAS u32x2*)(P + t * S72 + s0) = wv; }
    }
    {
        const f32x4 dl = *(const LAS f32x4*)(DL + 16 * w + 4 * fq);
        bf16x8 a[2];
#pragma unroll
        for (int ks = 0; ks < 2; ++ks) a[ks] = *(const LAS bf16x8*)(KDT + (16 * w + fr) * S72 + ks * 32 + 8 * fq);
#pragma unroll
        for (int cb = 0; cb < 8; ++cb) { f32x4 s = Sacc[cb] * dl;
#pragma unroll
            for (int ks = 0; ks < 2; ++ks) { const bf16x8 b = *(const LAS bf16x8*)(VT + (cb * 16 + fr) * S72 + ks * 32 + 8 * fq); s = mfma16(a[ks], b, s); }
            Sacc[cb] = s; }
    }
    HG_BAR();
    f32x4 oacc[4];
    const int tb = w & 3, ch = w >> 2;
#pragma unroll
    for (int i = 0; i < 4; ++i) oacc[i] = (f32x4){0.f, 0.f, 0.f, 0.f};
#pragma unroll
    for (int ks = 0; ks < 2; ++ks) { const bf16x8 b = *(const LAS bf16x8*)(P + (tb * 16 + fr) * S72 + ks * 32 + 8 * fq);
#pragma unroll
        for (int i = 0; i < 4; ++i) { const bf16x8 a = *(const LAS bf16x8*)(VT + ((ch * 4 + i) * 16 + fr) * S72 + ks * 32 + 8 * fq); oacc[i] = mfma16(a, b, oacc[i]); } }
#pragma unroll
    for (int ks = 0; ks < 4; ++ks) { const bf16x8 b = *(const LAS bf16x8*)(QD + (tb * 16 + fr) * SQ + ks * 32 + 8 * fq);
#pragma unroll
        for (int i = 0; i < 4; ++i) { const bf16x8 a = *(const LAS bf16x8*)(ST + ((ch * 4 + i) * 16 + fr) * SQ + ks * 32 + 8 * fq); oacc[i] = mfma16(a, b, oacc[i]); } }
    float ss = 0.f;
#pragma unroll
    for (int i = 0; i < 4; ++i) ss += (oacc[i][0] * oacc[i][0] + oacc[i][1] * oacc[i][1]) + (oacc[i][2] * oacc[i][2] + oacc[i][3] * oacc[i][3]);
    ss += __shfl_xor(ss, 16); ss += __shfl_xor(ss, 32);
    if (lane < 16) RSS[ch * 64 + tb * 16 + lane] = ss;
    HG_BAR();
    const int t = tb * 16 + fr;
    const float rn = 1.0f / sqrtf((RSS[t] + RSS[64 + t]) * (1.0f / 128.0f) + EPS);
    if (t < nvalid) {
#pragma unroll
        for (int i = 0; i < 4; ++i) { const int cc = (ch * 4 + i) * 16 + 4 * fq; const u32x2 gw = sgv[i];
            u32x2 wv; wv.x = pk2(oacc[i][0] * rn * bflo(gw.x), oacc[i][1] * rn * bfhi(gw.x)); wv.y = pk2(oacc[i][2] * rn * bflo(gw.y), oacc[i][3] * rn * bfhi(gw.y));
            *(u32x2*)(AP + (size_t)(r0 + t) * D + h * 128 + cc) = wv; }
    }
}
}

__device__ __forceinline__ void phase_pool(Frame& F, const bf16* PA, bf16* AP) {
    for (int it = F.vcu; it < 513 * 4; it += F.G) {
        const int rb = it >> 2, g = it & 3, wn = 2 << g, c = g * 128 + 2 * F.lane;
        const int rlast = rb * 64 + 8 * F.wave + 7;
        if (rb == 512 && F.wave >= 2) continue;
        unsigned v[23];
#pragma unroll
        for (int d = 0; d < 23; ++d) { int pr = (d < wn + 7) ? prev_row(rlast, d) : -1; v[d] = pr >= 0 ? *(const unsigned*)(PA + (size_t)pr * NA + 2048 + c) : 0u; }
#pragma unroll
        for (int j = 0; j < 8; ++j) { const int d0 = 7 - j, r = rlast - d0; float s0 = 0.f, s1 = 0.f;
#pragma unroll
            for (int jj = 0; jj < 16; ++jj) if (jj < wn) { s0 += bflo(v[d0 + jj]); s1 += bfhi(v[d0 + jj]); }
            int cnt = wn; if (r >= META0) { const int m1 = r - META0 + 1; cnt = m1 < wn ? m1 : wn; }
            const float ic = 1.0f / (float)cnt;
            *(unsigned*)(AP + (size_t)r * D + 512 + c) = pk2(s0 * ic - bflo(v[d0]), s1 * ic - bfhi(v[d0])); }
    }
}

__device__ __forceinline__ void hgrn_store_state(float* dst, const f32x4 (&Sacc)[8], int tid) {
#pragma unroll
    for (int cb = 0; cb < 8; ++cb)
#pragma unroll
        for (int i = 0; i < 4; ++i) dst[(cb * 4 + i) * 512 + tid] = Sacc[cb][i];
}
__device__ __forceinline__ void phase_hgrn_a(Frame& F, int l, const bf16* PA, bf16* AP) {
    unsigned char* big = F.ws + WS_BIG;
    const float* LB = (const float*)(F.ws + WS_LB) + l * 512;
    const int w = F.wave, lane = F.lane;
    f32x4 Sacc[8];
    if (F.vcu < 4) {
        const int h = F.vcu; const float lb0 = LB[h * 128 + 2 * lane], lb1 = LB[h * 128 + 2 * lane + 1];
#pragma unroll
        for (int cb = 0; cb < 8; ++cb) Sacc[cb] = (f32x4){0.f, 0.f, 0.f, 0.f};
        hg::CIn ci;
        hg::load_cin<true>(ci, PA, META0, h, NMETA, w, lane);
        hg::chunk_c(F.lds, ci, PA, AP, META0, h, NMETA, lb0, lb1, Sacc, w, lane);
        hgrn_store_state((float*)(big + B_SM) + (size_t)h * 16384, Sacc, F.tid);
        HG_BAR();
    }
    for (int u = F.vcu; u < 256; u += F.G) {
        const int b = u >> 6, h = (u >> 4) & 3, j = u & 15; float carry0 = 0.f, carry1 = 0.f;
        const float lb0 = LB[h * 128 + 2 * lane], lb1 = LB[h * 128 + 2 * lane + 1];
#pragma unroll
        for (int cb = 0; cb < 8; ++cb) Sacc[cb] = (f32x4){0.f, 0.f, 0.f, 0.f};
        const int rbase = b * SEQ + 512 * j;
        hg::CIn cur, nxt;
        hg::load_cin<false>(cur, PA, rbase + 64 * 7, h, 64, w, lane);
#pragma unroll 1
        for (int i = 7; i >= 0; --i) {
            if (i > 0) hg::load_cin<false>(nxt, PA, rbase + 64 * (i - 1), h, 64, w, lane);
            hg::chunk_a(F.lds, cur, 64, lb0, lb1, carry0, carry1, Sacc, w, lane);
            cur = nxt;
        }
        hgrn_store_state((float*)(big + B_KV) + (size_t)u * 16384, Sacc, F.tid);
        if (w == 0) { float* DD = (float*)(big + B_DD) + u * 128; DD[2 * lane] = __expf(carry0); DD[2 * lane + 1] = __expf(carry1); }
        HG_BAR();
    }
}
__device__ __forceinline__ void phase_hgrn_b(Frame& F) {
    unsigned char* big = F.ws + WS_BIG;
    const float* KV = (const float*)(big + B_KV); float* SS = (float*)(big + B_SS); const float* SM = (const float*)(big + B_SM); const float* DD = (const float*)(big + B_DD);
    for (int g = F.vcu * 512 + F.tid; g < 16 * 16384; g += F.G * 512) {
        const int bh = g >> 14, e = g & 16383, h = bh & 3, tidx = e & 511, reg = e >> 9;
        const int k = 16 * (tidx >> 6) + 4 * ((tidx & 63) >> 4) + (reg & 3);
        float kv[16], dd[16];
#pragma unroll
        for (int j = 0; j < 16; ++j) { const int u = bh * 16 + j; kv[j] = KV[(size_t)u * 16384 + e]; dd[j] = DD[u * 128 + k]; }
        float s = SM[(size_t)h * 16384 + e];
#pragma unroll
        for (int j = 0; j < 16; ++j) { const int u = bh * 16 + j; SS[(size_t)u * 16384 + e] = s; s = dd[j] * s + kv[j]; }
    }
}
__device__ __forceinline__ void phase_hgrn_c(Frame& F, int l, const bf16* PA, bf16* AP) {
    unsigned char* big = F.ws + WS_BIG;
    const float* LB = (const float*)(F.ws + WS_LB) + l * 512;
    const int w = F.wave, lane = F.lane;
    f32x4 Sacc[8];
    for (int u = F.vcu; u < 256; u += F.G) {
        const int b = u >> 6, h = (u >> 4) & 3, j = u & 15;
        const float lb0 = LB[h * 128 + 2 * lane], lb1 = LB[h * 128 + 2 * lane + 1];
        const int rbase = b * SEQ + 512 * j;
        hg::CIn cur, nxt;
        hg::load_cin<true>(cur, PA, rbase, h, 64, w, lane);
        const float* src = (const float*)(big + B_SS) + (size_t)u * 16384;
#pragma unroll
        for (int cb = 0; cb < 8; ++cb)
#pragma unroll
            for (int i = 0; i < 4; ++i) Sacc[cb][i] = src[(cb * 4 + i) * 512 + F.tid];
#pragma unroll 1
        for (int i = 0; i < 8; ++i) {
            if (i < 7) hg::load_cin<true>(nxt, PA, rbase + 64 * (i + 1), h, 64, w, lane);
            hg::chunk_c(F.lds, cur, PA, AP, rbase + 64 * i, h, 64, lb0, lb1, Sacc, w, lane);
            cur = nxt;
        }
        HG_BAR();
    }
}

__device__ __forceinline__ void phase_ln_res(Frame& F, const float* Y, const float* gain, const float* xbase) {
    const int gw = F.vcu * 8 + F.wave, NGW = F.G * 8;
    bf16* HB = (bf16*)(F.ws + WS_HB); float* RS = (float*)(F.ws + WS_RS);
    f32x4 gv[4];
#pragma unroll
    for (int j = 0; j < 4; ++j) gv[j] = *((const f32x4*)gain + F.lane + 64 * j);
    for (int r = gw; r < MX + NMETA; r += NGW) {
        float* hp = hrow_ptr(F, r);
        const float* bp = (xbase && r < MX) ? xbase + (size_t)r * D : hp;
        f32x4 y[4], hv[4]; float ss = 0.f;
#pragma unroll
        for (int j = 0; j < 4; ++j) { y[j] = *((const f32x4*)(Y + (size_t)r * D) + F.lane + 64 * j); hv[j] = *((const f32x4*)bp + F.lane + 64 * j);
            ss += (y[j].x * y[j].x + y[j].y * y[j].y) + (y[j].z * y[j].z + y[j].w * y[j].w); }
        const float rn = 1.0f / sqrtf(wave_sum(ss) * (1.0f / D) + EPS);
        float s2 = 0.f;
#pragma unroll
        for (int j = 0; j < 4; ++j) { hv[j] = hv[j] + y[j] * rn * gv[j]; s2 += (hv[j].x * hv[j].x + hv[j].y * hv[j].y) + (hv[j].z * hv[j].z + hv[j].w * hv[j].w); }
        s2 = wave_sum(s2);
#pragma unroll
        for (int j = 0; j < 4; ++j) { *((f32x4*)hp + F.lane + 64 * j) = hv[j];
            u32x2 w; w.x = pk2(hv[j].x, hv[j].y); w.y = pk2(hv[j].z, hv[j].w); *((u32x2*)(HB + (size_t)r * D) + F.lane + 64 * j) = w; }
        if (F.lane == 0) RS[r] = 1.0f / sqrtf(s2 * (1.0f / D) + EPS);
    }
}

__device__ __forceinline__ float gelu_tanh(float x) {
    const float y = 0.7978845608028654f * (x + 0.044715f * x * x * x);
    const float e = __expf(-2.0f * fabsf(y)); const float th = (1.0f - e) / (1.0f + e);
    return 0.5f * x * (1.0f + (y >= 0.f ? th : -th));
}
__device__ __forceinline__ void phase_conv(Frame& F, const Args& A, int l, const bf16* G, bf16* U) {
    const float* cw = A.in[16] + (size_t)l * 3 * DFF; const float* cb = A.in[17] + (size_t)l * DFF;
    constexpr int CG = DFF / 8;
    for (int idx = F.vcu * 512 + F.tid; idx < (MX + NMETA) * CG; idx += F.G * 512) {
        const int r = idx / CG, c = (idx % CG) * 8;
        const int r1 = prev_row(r, 1), r2 = prev_row(r, 2);
        const u32x4 z = (u32x4){0u, 0u, 0u, 0u};
        const u32x4 g2 = *(const u32x4*)(G + (size_t)r * DFF + c);
        const u32x4 g1 = r1 >= 0 ? *(const u32x4*)(G + (size_t)r1 * DFF + c) : z;
        const u32x4 g0 = r2 >= 0 ? *(const u32x4*)(G + (size_t)r2 * DFF + c) : z;
        const u32x4 uu = *(const u32x4*)(U + (size_t)r * DFF + c);
        const unsigned a0[4] = {g0.x, g0.y, g0.z, g0.w}, a1[4] = {g1.x, g1.y, g1.z, g1.w}, a2[4] = {g2.x, g2.y, g2.z, g2.w}, au[4] = {uu.x, uu.y, uu.z, uu.w};
        unsigned o[4];
#pragma unroll
        for (int e = 0; e < 4; ++e) { const int cc = c + 2 * e;
            const float x0 = cb[cc] + cw[cc] * bflo(a0[e]) + cw[DFF + cc] * bflo(a1[e]) + cw[2 * DFF + cc] * bflo(a2[e]);
            const float x1 = cb[cc + 1] + cw[cc + 1] * bfhi(a0[e]) + cw[DFF + cc + 1] * bfhi(a1[e]) + cw[2 * DFF + cc + 1] * bfhi(a2[e]);
            o[e] = pk2(gelu_tanh(x0) * bflo(au[e]), gelu_tanh(x1) * bfhi(au[e])); }
        *(u32x4*)(U + (size_t)r * DFF + c) = (u32x4){o[0], o[1], o[2], o[3]};
    }
}

namespace mg {
__device__ __forceinline__ f32x4 mfma16(bf16x8 a, bf16x8 b, f32x4 c) { return __builtin_amdgcn_mfma_f32_16x16x32_bf16(a, b, c, 0, 0, 0); }
__device__ __forceinline__ f32x4 dot(const bf16* Ap, const bf16* Bp, int K, f32x4 acc) {
#pragma unroll 8
    for (int k = 0; k < K; k += 32) { const bf16x8 a = *(const bf16x8*)(Ap + k); const bf16x8 b = *(const bf16x8*)(Bp + k); acc = mfma16(b, a, acc); }
    return acc;
}
__device__ __forceinline__ u32x2 pack4(f32x4 v) { u32x2 w; w.x = pk2(v[0], v[1]); w.y = pk2(v[2], v[3]); return w; }
__device__ __forceinline__ f32x4 unpack4(u32x2 w) { return (f32x4){bflo(w.x), bfhi(w.x), bflo(w.y), bfhi(w.y)}; }
}
#define MG_LOOP(NBLK) const int gw_ = F.vcu * 8 + F.wave, ngw_ = F.G * 8, fr = F.lane & 15, fq = F.lane >> 4, r = META0 + fr; const f32x4 z4 = (f32x4){0.f, 0.f, 0.f, 0.f}; (void)z4; for (int nb = gw_; nb < (NBLK); nb += ngw_)
__device__ __forceinline__ void meta_proj_a(Frame& F, const bf16* HB, const float* RS, const bf16* W, bf16* PA) {
    MG_LOOP(NA / 16) { const int n0 = 16 * nb;
        f32x4 v = mg::dot(HB + (size_t)r * D + 8 * fq, W + (size_t)(n0 + fr) * D + 8 * fq, D, z4) * RS[r];
        if (n0 >= 1536 && n0 < 2048) {
#pragma unroll
            for (int e = 0; e < 4; ++e) v[e] = fsigmoid(v[e]); }
        *(u32x2*)(PA + (size_t)r * NA + n0 + 4 * fq) = mg::pack4(v); }
}
__device__ __forceinline__ void meta_gates(Frame& F, const bf16* HB, const float* RS, const bf16* W, bf16* GT) {
    MG_LOOP(D / 16) { const int c0 = 16 * nb, rowa = 256 * (c0 >> 7) + (c0 & 127);
        const float s = RS[r];
        const f32x4 ga = mg::dot(HB + (size_t)r * D + 8 * fq, W + (size_t)(rowa + fr) * D + 8 * fq, D, z4) * s;
        const f32x4 gb = mg::dot(HB + (size_t)r * D + 8 * fq, W + (size_t)(rowa + 128 + fr) * D + 8 * fq, D, z4) * s;
        f32x4 R, SB;
#pragma unroll
        for (int e = 0; e < 4; ++e) { const float ea = __expf(-ga[e]), eb = __expf(-gb[e]); SB[e] = 1.0f / (1.0f + eb); R[e] = (1.0f + eb) / (1.0f + ea); }
        *(u32x2*)(GT + (size_t)r * NG + c0 + 4 * fq) = mg::pack4(R); *(u32x2*)(GT + (size_t)r * NG + 1024 + c0 + 4 * fq) = mg::pack4(SB); }
}
__device__ __forceinline__ void meta_z(Frame& F, const bf16* AP, const bf16* GT, const bf16* W, bf16* Z) {
    MG_LOOP(D / 16) { const int n0 = 16 * nb;
        f32x4 v = mg::dot(AP + (size_t)r * D + 8 * fq, W + (size_t)(n0 + fr) * D + 8 * fq, 512, z4);
        v = v * mg::unpack4(*(const u32x2*)(GT + (size_t)r * NG + n0 + 4 * fq));
        v = mg::dot(AP + (size_t)r * D + 512 + 8 * fq, W + (size_t)(n0 + fr) * D + 512 + 8 * fq, 512, v);
        v = v * mg::unpack4(*(const u32x2*)(GT + (size_t)r * NG + 1024 + n0 + 4 * fq));
        *(u32x2*)(Z + (size_t)r * D + n0 + 4 * fq) = mg::pack4(v); }
}
__device__ __forceinline__ void meta_f32(Frame& F, const bf16* A, int lda, int K, const bf16* W, float* Y) {
    MG_LOOP(D / 16) { const int n0 = 16 * nb;
        const f32x4 v = mg::dot(A + (size_t)r * lda + 8 * fq, W + (size_t)(n0 + fr) * K + 8 * fq, K, z4);
        *(f32x4*)(Y + (size_t)r * D + n0 + 4 * fq) = v; }
}
__device__ __forceinline__ void meta_gu(Frame& F, const bf16* HB, const float* RS, const bf16* W, bf16* G, bf16* U) {
    MG_LOOP(DFF / 16) { const int c0 = 16 * nb, rowg = 256 * (c0 >> 7) + (c0 & 127);
        const float s = RS[r];
        const f32x4 g = mg::dot(HB + (size_t)r * D + 8 * fq, W + (size_t)(rowg + fr) * D + 8 * fq, D, z4) * s;
        const f32x4 u = mg::dot(HB + (size_t)r * D + 8 * fq, W + (size_t)(rowg + 128 + fr) * D + 8 * fq, D, z4) * s;
        *(u32x2*)(G + (size_t)r * DFF + c0 + 4 * fq) = mg::pack4(g); *(u32x2*)(U + (size_t)r * DFF + c0 + 4 * fq) = mg::pack4(u); }
}

constexpr int PH_PER_LAYER = 12, N_PHASES = 1 + DEPTH * PH_PER_LAYER;

__global__ void __launch_bounds__(512, 2) trunk_fwd(Args args) {
    extern __shared__ __attribute__((aligned(16))) unsigned char lds_raw[];
    Frame F;
    F.lds = (LAS unsigned char*)lds_raw;
    F.tid = threadIdx.x; F.lane = F.tid & 63; F.wave = __builtin_amdgcn_readfirstlane(F.tid >> 6);
    F.G = gridDim.x; { const int bx = blockIdx.x; F.vcu = (F.G % 8 == 0) ? (bx % 8) * (F.G / 8) + bx / 8 : bx; }
    F.out = args.out; F.ws = args.ws;
    volatile LAS unsigned* MISC = (volatile LAS unsigned*)(F.lds + MISC_OFF);
    if (F.tid < 64) MISC[F.tid] = 0u;
    __syncthreads();
#if MK_ONE_LAUNCH
    XcdBarrier bar = xcd_barrier_post((unsigned*)(F.ws + WS_CTL) + CW_BAR, MISC + 8);
#define GRID_BAR() xcd_barrier(bar)
#else
#define GRID_BAR() do {} while (0)
#endif
    const int lo = args.ph_lo, hi = args.ph_hi;
    int ph = 0;
#ifndef MK_ONLY
#define MK_ONLY -1
#endif
#ifndef MK_DUP
#define MK_DUP 0
#endif
    constexpr int cbase = __COUNTER__ + 1;
#define PHASE(...) do { constexpr int pid_ = __COUNTER__ - cbase; constexpr int dupn_ = (pid_ < 13 && ((MK_DUP >> pid_) & 1)) ? 2 : 1; if constexpr (MK_ONLY < 0 || MK_ONLY == pid_) { if (lo <= ph && ph < hi) { for (int rep_ = 0; rep_ < dupn_; ++rep_) { \
        { int t_ = threadIdx.x; asm volatile("" : "+v"(t_)); F.tid = t_; F.lane = t_ & 63; F.wave = __builtin_amdgcn_readfirstlane(t_ >> 6); LAS unsigned char* lp_ = (LAS unsigned char*)lds_raw; asm volatile("" : "+s"(lp_)); F.lds = lp_; \
          unsigned char* wp_ = args.ws; asm volatile("" : "+s"(wp_)); F.ws = wp_; int bx_ = blockIdx.x, g_ = gridDim.x; asm volatile("" : "+s"(bx_), "+s"(g_)); F.bx = bx_; F.G = g_; F.vcu = (g_ % 8 == 0) ? (bx_ % 8) * (g_ / 8) + bx_ / 8 : bx_; } \
        __VA_ARGS__; if (ph + 1 < hi || rep_ + 1 < dupn_) GRID_BAR(); } } } ++ph; } while (0)
#define WL_(off) ((const bf16*)(F.ws + WS_W + (size_t)l * WL_BYTES + (off)))
#define BIG_(T, off) ((T*)(F.ws + WS_BIG + (off)))
#define HB_ ((bf16*)(F.ws + WS_HB))
#define RS_ ((const float*)(F.ws + WS_RS))

    PHASE(phase_prologue(F, args));
    for (int l = 0; l < DEPTH; ++l) {
        PHASE({ meta_proj_a(F, HB_, RS_, WL_(WL_INA), BIG_(bf16, B_PA));
                pg8::Gemm g{HB_, WL_(WL_INA), D, D, D, 0}; pg8::StaticOrder S; S.init(MX, NA, F.G, F.bx);
                pg8::EpiProjA E{BIG_(bf16, B_PA), RS_}; pg8::gemm_phase<pg8::EpiProjA, pg8::StaticOrder, true>(F.lds, g, S, E, F.tid); });
        PHASE({ phase_pool(F, BIG_(bf16, B_PA), BIG_(bf16, B_AP)); phase_hgrn_a(F, l, BIG_(bf16, B_PA), BIG_(bf16, B_AP)); });
        PHASE(phase_hgrn_b(F));
        PHASE(phase_hgrn_c(F, l, BIG_(bf16, B_PA), BIG_(bf16, B_AP)));
        PHASE({ meta_gates(F, HB_, RS_, WL_(WL_G), BIG_(bf16, B_PA));
                pg8::Gemm g{HB_, WL_(WL_G), D, D, D, 0}; pg8::StaticOrder S; S.init(MX, NG, F.G, F.bx);
                pg8::EpiGates E{BIG_(bf16, B_PA), RS_}; pg8::gemm_phase<pg8::EpiGates, pg8::StaticOrder, true>(F.lds, g, S, E, F.tid); });
        PHASE({ meta_z(F, BIG_(bf16, B_AP), BIG_(bf16, B_PA), WL_(WL_Z), BIG_(bf16, B_Z));
                pg8::Gemm g{BIG_(bf16, B_AP), WL_(WL_Z), D, D, 512, 512}; pg8::PairOrder S; S.init(MX, D, F.G, F.bx);
                pg8::EpiZ E{BIG_(bf16, B_PA), BIG_(bf16, B_Z)}; pg8::gemm_phase<pg8::EpiZ, pg8::PairOrder, true>(F.lds, g, S, E, F.tid); });
        PHASE({ meta_f32(F, BIG_(bf16, B_Z), D, D, WL_(WL_OUT), BIG_(float, B_PA));
                pg8::Gemm g{BIG_(bf16, B_Z), WL_(WL_OUT), D, D, D, 0}; pg8::StaticOrder S; S.init(MX, D, F.G, F.bx);
                pg8::EpiF32 E{BIG_(float, B_PA), D}; pg8::gemm_phase<pg8::EpiF32, pg8::StaticOrder, true>(F.lds, g, S, E, F.tid); });
        PHASE(phase_ln_res(F, BIG_(float, B_PA), args.in[3] + l * D, l == 0 ? args.in[0] : nullptr));
        PHASE({ meta_gu(F, HB_, RS_, WL_(WL_GU), BIG_(bf16, B_G), BIG_(bf16, B_U));
                pg8::Gemm g{HB_, WL_(WL_GU), D, D, D, 0}; pg8::StaticOrder S; S.init(MX, NGU, F.G, F.bx);
                pg8::EpiGU E{BIG_(bf16, B_G), BIG_(bf16, B_U), RS_}; pg8::gemm_phase<pg8::EpiGU, pg8::StaticOrder, true>(F.lds, g, S, E, F.tid); });
        PHASE(phase_conv(F, args, l, BIG_(bf16, B_G), BIG_(bf16, B_U)));
        PHASE({ meta_f32(F, BIG_(bf16, B_U), DFF, DFF, WL_(WL_DN), BIG_(float, B_G));
                pg8::Gemm g{BIG_(bf16, B_U), WL_(WL_DN), DFF, DFF, DFF, 0}; pg8::StaticOrder S; S.init(MX, D, F.G, F.bx);
                pg8::EpiF32 E{BIG_(float, B_G), D}; pg8::gemm_phase<pg8::EpiF32, pg8::StaticOrder, true>(F.lds, g, S, E, F.tid); });
        PHASE(phase_ln_res(F, BIG_(float, B_G), args.in[13] + l * D, nullptr));
    }
}

extern "C" void kernel_launch(void* const* d_in, const int* in_sizes, int n_in, void* d_out, int out_size, void* d_ws, size_t ws_size, hipStream_t stream) {
    static int grid = 0;
    if (grid == 0) {
        if (n_in != 19 || out_size != MX * D || ws_size < WS_END) { fprintf(stderr, "kernel_launch: unexpected problem (n_in %d out %d ws %zu, need %zu)\n", n_in, out_size, ws_size, (size_t)WS_END); grid = -1; return; }
        int dev = 0, cus = 0;
        if (hipGetDevice(&dev) != hipSuccess || hipDeviceGetAttribute(&cus, hipDeviceAttributeMultiprocessorCount, dev) != hipSuccess) { grid = -1; return; }
        if (hipFuncSetAttribute((const void*)trunk_fwd, hipFuncAttributeMaxDynamicSharedMemorySize, LDS_BYTES) != hipSuccess) { fprintf(stderr, "kernel_launch: hipFuncSetAttribute failed\n"); grid = -1; return; }
        (void)hipGetLastError();
        grid = cus;
    }
    if (grid < 0) return;
    (void)hipMemsetAsync((char*)d_ws + WS_CTL, 0, CTL_BYTES, stream);
    Args a{};
    for (int i = 0; i < 19; ++i) a.in[i] = (const float*)d_in[i];
    a.out = (float*)d_out; a.ws = (unsigned char*)d_ws;
#if MK_ONE_LAUNCH
    a.ph_lo = 0; a.ph_hi = N_PHASES; a.li = 0;
    hipLaunchKernelGGL(trunk_fwd, dim3(grid), dim3(512), LDS_BYTES, stream, a);
#else
    for (int p = 0; p < N_PHASES; ++p) { a.ph_lo = p; a.ph_hi = p + 1; a.li = p; hipLaunchKernelGGL(trunk_fwd, dim3(grid), dim3(512), LDS_BYTES, stream, a); }
#endif
}
```
